# Optimizing an MI355X kernel written in HIP

```python
import math
import jax, jax.numpy as jnp
from jax import lax
import numpy as np

D_MODEL = 1024
BATCH = 4
SEQ = 4096
DEPTH = 4

N_MIXERS = 2
N_POOL_LAYERS = (DEPTH + 1) // 2
N_MLSTM_LAYERS = DEPTH // 2

POOL_WINDOWS = (2, 4, 8, 16)
N_POOL_GROUPS = len(POOL_WINDOWS)
POOL_GROUP_DIM = D_MODEL // N_POOL_GROUPS

N_HEADS = 4
DV = D_MODEL // N_HEADS
DQK = DV // 2
CHUNK = 64
QK_W = N_HEADS * DQK
V_W = N_HEADS * DV
MLSTM_IN_W = 2 * QK_W + 2 * V_W + 2 * N_HEADS

D_FF = int(math.ceil(8 * D_MODEL / 3 / 256) * 256)

EPS = 1e-6

kernel_name = "hybrid_pool_mlstm_swiglu_trunk"


def rms_norm(x, g):
    xf = x.astype(jnp.float32)
    y = xf * lax.rsqrt(jnp.mean(xf * xf, axis=-1, keepdims=True) + EPS)
    return y.astype(x.dtype) * g


def pool_mixer(x, w, scale):
    B, S, D = x.shape
    xg = x.reshape(B, S, N_POOL_GROUPS, POOL_GROUP_DIM).astype(jnp.float32)
    cs = jnp.cumsum(xg, axis=1)
    pos = jnp.arange(1, S + 1, dtype=jnp.float32)
    outs = []
    for g, win in enumerate(POOL_WINDOWS):
        c = cs[:, :, g]
        prev = jnp.pad(c[:, :S - win], ((0, 0), (win, 0), (0, 0)))
        cnt = jnp.minimum(pos, float(win))[None, :, None]
        outs.append((c - prev) / cnt)
    pooled = jnp.stack(outs, axis=2) - xg
    y = jnp.einsum('bsgc,gcd->bsgd', pooled.astype(x.dtype), w).reshape(B, S, D)
    return y * scale


def mlstm_chunkwise(q, k, v, i_pre, logf):
    B, H, S, _ = q.shape
    nc = S // CHUNK

    def to_chunks(a):
        a = a.reshape(a.shape[:2] + (nc, CHUNK) + a.shape[3:])
        return jnp.moveaxis(a, 2, 0)

    xs = (to_chunks(q), to_chunks(k), to_chunks(v), to_chunks(i_pre), to_chunks(logf))
    causal = jnp.tril(jnp.ones((CHUNK, CHUNK), dtype=bool))

    def step(carry, inp):
        C, n, m = carry
        qc, kc, vc, ic, fc = inp
        b = jnp.cumsum(fc, axis=-1)
        log_d = b[..., :, None] - b[..., None, :] + ic[..., None, :]
        log_d = jnp.where(causal, log_d, -jnp.inf)
        log_inter = b + m[..., None]
        m_t = jnp.maximum(log_inter, jnp.max(log_d, axis=-1))
        d = jnp.exp(log_d - m_t[..., None])
        inter = jnp.exp(log_inter - m_t)
        s = jnp.einsum('bhtk,bhsk->bhts', qc, kc) * d
        num = inter[..., None] * jnp.einsum('bhtk,bhkv->bhtv', qc, C) \
            + jnp.einsum('bhts,bhsv->bhtv', s, vc)
        den = inter * jnp.einsum('bhtk,bhk->bht', qc, n) + jnp.sum(s, axis=-1)
        h = num / jnp.maximum(jnp.abs(den), jnp.exp(-m_t))[..., None]
        m_new = m_t[..., -1]
        decay = jnp.exp(b[..., -1] + m - m_new)
        w = jnp.exp(b[..., -1:] - b + ic - m_new[..., None])
        kw = kc * w[..., None]
        C_new = decay[..., None, None] * C + jnp.einsum('bhsk,bhsv->bhkv', kw, vc)
        n_new = decay[..., None] * n + jnp.sum(kw, axis=2)
        return (C_new, n_new, m_new), h

    init = (jnp.zeros((B, H, DQK, DV), jnp.float32),
            jnp.zeros((B, H, DQK), jnp.float32),
            jnp.zeros((B, H), jnp.float32))
    _, hs = lax.scan(step, init, xs)
    return jnp.moveaxis(hs, 0, 2).reshape(B, H, S, DV)


def mlstm_mixer(x, w_in, gate_bias, head_norm, w_out):
    B, S, _ = x.shape
    proj = x @ w_in
    q, k, v, o, gates = jnp.split(proj, [QK_W, 2 * QK_W, 2 * QK_W + V_W, 2 * QK_W + 2 * V_W], axis=-1)
    gates = gates.astype(jnp.float32) + gate_bias.astype(jnp.float32)
    i_pre = jnp.transpose(gates[..., :N_HEADS], (0, 2, 1))
    logf = jax.nn.log_sigmoid(jnp.transpose(gates[..., N_HEADS:], (0, 2, 1)))

    def heads(a, d):
        return jnp.transpose(a.reshape(B, S, N_HEADS, d), (0, 2, 1, 3)).astype(jnp.float32)

    qh = heads(q, DQK) * (DQK ** -0.5)
    kh = heads(k, DQK)
    vh = heads(v, DV)
    h = mlstm_chunkwise(qh, kh, vh, i_pre, logf)
    h = jnp.transpose(h, (0, 2, 1, 3))
    h = h * lax.rsqrt(jnp.mean(h * h, axis=-1, keepdims=True) + EPS)
    h = h.reshape(B, S, V_W).astype(x.dtype) * head_norm
    h = h * jax.nn.sigmoid(o)
    return h @ w_out


def swiglu(x, w_in, w_out):
    gu = x @ w_in
    g, u = gu[..., :D_FF], gu[..., D_FF:]
    return (jax.nn.silu(g) * u) @ w_out


def setup_inputs(seed: int = 0) -> dict:
    key = jax.random.key(seed)
    ks = jax.random.split(key, 16)
    f32 = jnp.float32
    nrm = lambda k, shape, s: jax.random.normal(k, shape, f32) * s
    fgate_bias = jnp.linspace(3.0, 6.0, N_HEADS, dtype=f32)
    gate_bias = jnp.concatenate([
        nrm(ks[6], (N_MLSTM_LAYERS, N_HEADS), 0.1),
        fgate_bias[None, :] + nrm(ks[7], (N_MLSTM_LAYERS, N_HEADS), 0.1)], axis=-1)
    return {
        "x": nrm(ks[0], (BATCH, SEQ, D_MODEL), 1.0),
        "pool_norm": 1.0 + nrm(ks[1], (N_POOL_LAYERS, D_MODEL), 0.02),
        "pool_w": nrm(ks[2], (N_POOL_LAYERS, N_POOL_GROUPS, POOL_GROUP_DIM, POOL_GROUP_DIM), POOL_GROUP_DIM ** -0.5),
        "pool_scale": 0.5 + nrm(ks[3], (N_POOL_LAYERS, D_MODEL), 0.05),
        "mlstm_norm": 1.0 + nrm(ks[4], (N_MLSTM_LAYERS, D_MODEL), 0.02),
        "mlstm_w_in": nrm(ks[5], (N_MLSTM_LAYERS, D_MODEL, MLSTM_IN_W), D_MODEL ** -0.5),
        "mlstm_gate_bias": gate_bias,
        "mlstm_head_norm": 1.0 + nrm(ks[8], (N_MLSTM_LAYERS, V_W), 0.02),
        "mlstm_w_out": nrm(ks[9], (N_MLSTM_LAYERS, V_W, D_MODEL), V_W ** -0.5),
        "ffn_norm": 1.0 + nrm(ks[10], (DEPTH, D_MODEL), 0.02),
        "ffn_w_in": nrm(ks[11], (DEPTH, D_MODEL, 2 * D_FF), D_MODEL ** -0.5),
        "ffn_w_out": nrm(ks[12], (DEPTH, D_FF, D_MODEL), D_FF ** -0.5),
        "final_norm": 1.0 + nrm(ks[13], (D_MODEL,), 0.02),
    }


def reference(x, pool_norm, pool_w, pool_scale, mlstm_norm, mlstm_w_in, mlstm_gate_bias,
              mlstm_head_norm, mlstm_w_out, ffn_norm, ffn_w_in, ffn_w_out, final_norm):
    h = x
    for i in range(DEPTH):
        j = i // N_MIXERS
        if i % N_MIXERS == 0:
            h = h + pool_mixer(rms_norm(h, pool_norm[j]), pool_w[j], pool_scale[j])
        else:
            h = h + mlstm_mixer(rms_norm(h, mlstm_norm[j]), mlstm_w_in[j], mlstm_gate_bias[j],
                                mlstm_head_norm[j], mlstm_w_out[j])
        h = h + swiglu(rms_norm(h, ffn_norm[i]), ffn_w_in[i], ffn_w_out[i])
    return rms_norm(h, final_norm)
```

```cpp
#include <hip/hip_runtime.h>
#include <cstdio>
#include <cstdint>

#ifndef MK_N_LAUNCHES
#define MK_N_LAUNCHES 22
#endif
#ifndef PH_MASK
#define PH_MASK 0x1ff
#endif
#define PH_ON(k) ((PH_MASK >> (k)) & 1)

#define LAS __attribute__((address_space(3)))
#define GAS __attribute__((address_space(1)))
typedef unsigned short bf16_t;
typedef short bf16x8 __attribute__((ext_vector_type(8)));
typedef float f32x4 __attribute__((ext_vector_type(4)));
typedef float f32x2 __attribute__((ext_vector_type(2)));
typedef unsigned u32x4 __attribute__((ext_vector_type(4)));
typedef unsigned u32x2 __attribute__((ext_vector_type(2)));
typedef GAS unsigned gu32;

constexpr int D = 1024, BATCH = 4, SEQ = 4096, M = BATCH * SEQ, DEPTH = 4;
constexpr int NH = 4, DV = 256, DQK = 128, INW = 3080, INW_MAIN = 3072;
constexpr int DFF = 2816;
constexpr int LC = 256, NCH = SEQ / LC, NSTREAM = BATCH * NH;
constexpr float EPS = 1e-6f;
constexpr int NWAVES = 8, NTHREADS = 512;
constexpr int NPHASES = 22;

constexpr size_t MiB = 1u << 20;
constexpr size_t WS_CTL = 0, CTL_ZERO_BYTES = 64 * 1024;
constexpr size_t WS_WPOOL = 1 * MiB;
constexpr size_t WS_WG = 2 * MiB;
constexpr size_t WS_WIN = 3 * MiB;
constexpr size_t WS_WOUT = 15 * MiB;
constexpr size_t WS_WF1 = 19 * MiB;
constexpr size_t WS_WF2 = 63 * MiB;
constexpr size_t WS_HB = 85 * MiB;
constexpr size_t WS_SSQ = 117 * MiB;
constexpr size_t WS_GI = 118 * MiB;
constexpr size_t WS_GF = WS_GI + 256 * 1024;
constexpr size_t WS_TA = WS_GF + 256 * 1024;
constexpr size_t WS_TM = WS_TA + 256 * 1024;
constexpr size_t WS_TB = WS_TM + 256 * 1024;
constexpr size_t WS_MPREV = WS_TB + 256 * 1024;
constexpr size_t WS_NST = WS_MPREV + 4096;
constexpr size_t WS_R = 120 * MiB;
constexpr size_t WS_POOLED = WS_R;
constexpr size_t WS_HID = WS_R;
constexpr size_t WS_QKO = WS_R;
constexpr size_t WS_KT = WS_R + 64 * MiB;
constexpr size_t WS_VT = WS_R + 80 * MiB;
constexpr size_t WS_HG = WS_R + 112 * MiB;
constexpr size_t WS_CST = WS_R + 144 * MiB;
constexpr size_t WS_END = WS_R + 160 * MiB;
static_assert(WS_HID + (size_t)M * DFF * 2 <= WS_END && WS_NST + 16 * 16 * 128 * 4 <= WS_R && WS_WF2 + (size_t)4 * 1024 * 2816 * 2 <= WS_HB, "d_ws map");
constexpr int CW_BAR = 1024;

constexpr int RING_BYTES = 131072;
constexpr int LDSCTL_OFF = RING_BYTES, MISC_OFF = LDSCTL_OFF + 320;
constexpr int LDS_BYTES = 147456;

#define RLX_AGENT __ATOMIC_RELAXED, __HIP_MEMORY_SCOPE_AGENT
#define LDS_WAIT() asm volatile("s_waitcnt lgkmcnt(0)" ::: "memory")
#define VM_WAIT() asm volatile("s_waitcnt vmcnt(0)" ::: "memory")

typedef __bf16 bf16v2 __attribute__((ext_vector_type(2)));
__device__ __forceinline__ unsigned cvt_pk_bf16(float lo, float hi) { const bf16v2 r = __builtin_convertvector((f32x2){lo, hi}, bf16v2); return __builtin_bit_cast(unsigned, r); }
__device__ __forceinline__ float bf2f(unsigned short b) { return __uint_as_float(((unsigned)b) << 16); }
__device__ __forceinline__ float bflo(unsigned u) { return __uint_as_float(u << 16); }
__device__ __forceinline__ float bfhi(unsigned u) { return __uint_as_float(u & 0xffff0000u); }
__device__ __forceinline__ float wave_sum(float v) {
#pragma unroll
    for (int o = 1; o < 64; o <<= 1) v += __shfl_xor(v, o);
    return v;
}
__device__ __forceinline__ float rinv_of(const f32x4 s) { return 1.0f / sqrtf(((s.x + s.y) + (s.z + s.w)) * (1.0f / D) + EPS); }

namespace pg8 {
constexpr int BM = 256, BK = 64, HALF = 128, HTB = HALF * BK * 2, STAGE_BYTES = 8 * HTB, NXCD = 8, WGM = 8;
__host__ __device__ __forceinline__ int lds_byte(int r, int c) { const int st = (r >> 4) * 2 + (c >> 5), rr = r & 15, cc = c & 31, ob = rr * 64 + cc * 2; return st * 1024 + (ob ^ (((ob >> 9) & 1) << 5)); }
__host__ __device__ __forceinline__ void stage_rc(int b, int& R, int& C) { const int st = b / 1024, sb = b % 1024, swz = sb ^ (((sb >> 9) & 1) << 5); R = (st >> 1) * 16 + swz / 64; C = (st & 1) * 32 + (swz % 64) / 2; }
__host__ __device__ __forceinline__ int perm32(int rho) { const int n = rho >> 4, i = rho & 15; return 8 * (i >> 2) + 4 * n + (i & 3); }

struct Unit { int pm, pn; };
struct Gemm { const bf16_t* A; const bf16_t* Bt; int lda, K, grouped; };

struct StaticOrder {
    int nM, nN, nwg, G, c;
    __device__ void init(int M_, int N_, int G_, int c_) { nM = M_ / BM; nN = N_ / BM; nwg = nM * nN; G = G_; c = c_; }
    __device__ bool next(int i, Unit& u) const {
        const long L = (long)i * G + c; if (L >= nwg) return false;
        int wgid = (int)L; { const int q = nwg / NXCD, r = nwg % NXCD, xcd = wgid % NXCD, off = wgid / NXCD; wgid = (xcd < r ? xcd * (q + 1) : r * (q + 1) + (xcd - r) * q) + off; }
        const int nig = WGM * nN, gid = wgid / nig, fm = gid * WGM, gsz = (nM - fm) < WGM ? (nM - fm) : WGM;
        u.pm = fm + ((wgid % nig) % gsz); u.pn = (wgid % nig) / gsz; return true;
    }
};


struct EpiSwiglu {
    static constexpr bool PERM = true, AFTER_DRAIN = false;
    bf16_t* O; const float* ssq;
    __device__ __forceinline__ void operator()(const f32x4 (&acc)[2][2][4][2], const Unit& u, int wr, int wc, int fr, int fq) const {
        const int row0 = u.pm * BM + wr * 64 + fr, col0 = u.pn * 128 + wc * 32 + 8 * fq;
#pragma unroll
        for (int ai = 0; ai < 2; ++ai)
#pragma unroll
            for (int m = 0; m < 4; ++m) {
                const int row = row0 + ai * HALF + m * 16;
                const float ri = rinv_of(*(const f32x4*)(ssq + (size_t)row * 4));
                float h[8];
#pragma unroll
                for (int n = 0; n < 2; ++n)
#pragma unroll
                    for (int j = 0; j < 4; ++j) {
                        const float g = acc[ai][0][m][n][j] * ri, up = acc[ai][1][m][n][j] * ri;
                        h[n * 4 + j] = g * __builtin_amdgcn_rcpf(1.0f + __expf(-g)) * up;
                    }
                u32x4 w; w.x = cvt_pk_bf16(h[0], h[1]); w.y = cvt_pk_bf16(h[2], h[3]); w.z = cvt_pk_bf16(h[4], h[5]); w.w = cvt_pk_bf16(h[6], h[7]);
                *(u32x4*)(O + (size_t)row * DFF + col0) = w;
            }
    }
};
struct EpiInProj {
    static constexpr bool PERM = true, AFTER_DRAIN = false;
    bf16_t* QKO; bf16_t* KT; bf16_t* VT; const float* ssq;
    __device__ __forceinline__ void operator()(const f32x4 (&acc)[2][2][4][2], const Unit& u, int wr, int wc, int fr, int fq) const {
        const int row0 = u.pm * BM + wr * 64 + fr;
        const int pn = u.pn;
        const bool is_k = (pn == 2 || pn == 3), is_v = (pn >= 4 && pn < 8);
        const int ncol0 = (pn < 4 ? pn * 256 : (pn - 4) * 256) + wc * 32 + 8 * fq;
        const int bb = (u.pm * BM) / SEQ, t0 = (u.pm * BM) % SEQ + wr * 64 + fr;
#pragma unroll
        for (int ai = 0; ai < 2; ++ai)
#pragma unroll
            for (int m = 0; m < 4; ++m) {
                const int row = row0 + ai * HALF + m * 16, t = t0 + ai * HALF + m * 16;
                const float ri = rinv_of(*(const f32x4*)(ssq + (size_t)row * 4));
#pragma unroll
                for (int bj = 0; bj < 2; ++bj) {
                    float v[8];
#pragma unroll
                    for (int n = 0; n < 2; ++n)
#pragma unroll
                        for (int j = 0; j < 4; ++j) v[n * 4 + j] = acc[ai][bj][m][n][j] * ri;
                    u32x4 w; w.x = cvt_pk_bf16(v[0], v[1]); w.y = cvt_pk_bf16(v[2], v[3]); w.z = cvt_pk_bf16(v[4], v[5]); w.w = cvt_pk_bf16(v[6], v[7]);
                    if (!is_v) *(u32x4*)(QKO + (size_t)row * 2048 + ncol0 + bj * HALF) = w;
                    if (is_k) {
                        const int cs = (pn - 2) * 256 + bj * HALF + wc * 32 + 8 * fq;
                        bf16_t* p = KT + ((size_t)(bb * NH + cs / DQK) * DQK + (cs % DQK)) * SEQ + t;
                        const unsigned ww[4] = {w.x, w.y, w.z, w.w};
#pragma unroll
                        for (int e = 0; e < 4; ++e) { p[(size_t)(2 * e) * SEQ] = (bf16_t)(ww[e] & 0xffffu); p[(size_t)(2 * e + 1) * SEQ] = (bf16_t)(ww[e] >> 16); }
                    }
                    if (is_v) {
                        const int cs = bj * HALF + wc * 32 + 8 * fq;
                        bf16_t* p = VT + ((size_t)(bb * NH + (pn - 4)) * DV + cs) * SEQ + t;
                        const unsigned ww[4] = {w.x, w.y, w.z, w.w};
#pragma unroll
                        for (int e = 0; e < 4; ++e) { p[(size_t)(2 * e) * SEQ] = (bf16_t)(ww[e] & 0xffffu); p[(size_t)(2 * e + 1) * SEQ] = (bf16_t)(ww[e] >> 16); }
                    }
                }
            }
    }
};
struct EpiResid {
    static constexpr bool PERM = false, AFTER_DRAIN = true;
    const float* base; float* out; bf16_t* hb; float* ssq;
    __device__ __forceinline__ void fused(f32x4 (&acc)[2][2][4][2], const Unit& u, int wr, int wc, int fr, int fq, LAS unsigned char* lds, int wid, int lane) const {
        LAS float* P = (LAS float*)lds;
        const int col0 = u.pn * BM + wc * 32 + 4 * fq;
#pragma unroll
        for (int ai = 0; ai < 2; ++ai)
#pragma unroll
            for (int m = 0; m < 4; ++m) {
                const int r = ai * HALF + wr * 64 + m * 16 + fr; const size_t off = (size_t)(u.pm * BM + r) * D + col0; float ss = 0.f;
#pragma unroll
                for (int bj = 0; bj < 2; ++bj)
#pragma unroll
                    for (int n = 0; n < 2; ++n) {
                        const f32x4 bs = *(const f32x4*)(base + off + bj * HALF + n * 16); const f32x4 o = bs + acc[ai][bj][m][n];
                        *(f32x4*)(out + off + bj * HALF + n * 16) = o;
                        u32x2 w; w.x = cvt_pk_bf16(o[0], o[1]); w.y = cvt_pk_bf16(o[2], o[3]);
                        *(u32x2*)(hb + off + bj * HALF + n * 16) = w;
                        ss += (o[0] * o[0] + o[1] * o[1]) + (o[2] * o[2] + o[3] * o[3]);
                    }
                ss += __shfl_xor(ss, 16); ss += __shfl_xor(ss, 32);
                if (fq == 0) P[r * 4 + wc] = ss;
                asm volatile("" ::: "memory");
            }
        asm volatile("s_waitcnt lgkmcnt(0)" ::: "memory"); __builtin_amdgcn_s_barrier(); asm volatile("" ::: "memory");
        const int tid = wid * 64 + lane;
        if (tid < 256) { const f32x4 p = *(LAS f32x4*)(P + tid * 4); ssq[(size_t)(u.pm * BM + tid) * 4 + u.pn] = (p.x + p.y) + (p.z + p.w); }
    }
};

template <class Epi, bool ALIGN_EPI, bool SP2>
__device__ __forceinline__ void gemm_phase(LAS unsigned char* lds, const Gemm g, const StaticOrder& S, const Epi& E, const int tid) {
    const int wid = __builtin_amdgcn_readfirstlane(tid >> 6), lane = tid & 63, wr = wid >> 2, wc = wid & 3, fr = lane & 15, fq = lane >> 4;
    const int K = g.K, nt = K / BK, lda = g.lda;
    unsigned voffA[2], voffB[2];
#pragma unroll
    for (int i = 0; i < 2; ++i) { int R, C; stage_rc(tid * 16 + i * 8192, R, C); const int Rb = Epi::PERM ? ((R & ~31) + perm32(R & 31)) : R;
        voffA[i] = (unsigned)(R * lda + C) * 2u; voffB[i] = (unsigned)(Rb * K + C) * 2u; }
    const size_t kstep = (size_t)(BK * 2);
    const size_t hstepA = (size_t)HALF * lda * 2, hstepB = (size_t)HALF * K * 2;
    const size_t tstepA = 2 * hstepA, tstepB = 2 * hstepB;
    const size_t gstep = g.grouped ? (size_t)K * 2 : 0;
    const unsigned ldsw = (unsigned)wid * 1024u;
    const int aoff = lds_byte(wr * 64 + fr, fq * 8), boff = lds_byte(wc * 32 + fr, fq * 8);
#define PG8_SA(b, h) (((b) * 2 + (h)) * HTB)
#define PG8_SB(b, h) ((4 + (b) * 2 + (h)) * HTB)
#define PG8_STAGE(bufoff, gbase, voff) do { _Pragma("unroll") for (int _i = 0; _i < 2; ++_i) \
        __builtin_amdgcn_global_load_lds((const unsigned*)((const char*)(gbase) + (voff)[_i]), (LAS unsigned*)(lds + (bufoff) + ldsw + _i * 8192), 16, 0, 0); } while (0)
#define PG8_LDA(dst, b, h) do { _Pragma("unroll") for (int m = 0; m < 4; ++m) _Pragma("unroll") for (int k = 0; k < 2; ++k) dst[m][k] = *(const LAS bf16x8*)(lds + PG8_SA(b, h) + aoff + m * 2048 + k * 1024); } while (0)
#define PG8_LDB(dst, b, h) do { _Pragma("unroll") for (int n = 0; n < 2; ++n) _Pragma("unroll") for (int k = 0; k < 2; ++k) dst[n][k] = *(const LAS bf16x8*)(lds + PG8_SB(b, h) + boff + n * 2048 + k * 1024); } while (0)
#define PG8_MMA(ai, bj, At, Bt) do { __builtin_amdgcn_s_setprio(1); _Pragma("unroll") for (int m = 0; m < 4; ++m) _Pragma("unroll") for (int n = 0; n < 2; ++n) _Pragma("unroll") for (int k = 0; k < 2; ++k) \
        acc[ai][bj][m][n] = __builtin_amdgcn_mfma_f32_16x16x32_bf16(Bt[n][k], At[m][k], acc[ai][bj][m][n], 0, 0, 0); __builtin_amdgcn_s_setprio(0); } while (0)
#define PG8_WAIT_V(n) asm volatile("s_waitcnt vmcnt(" #n ")" ::: "memory")
#define PG8_WAIT_L(n) asm volatile("s_waitcnt lgkmcnt(" #n ")" ::: "memory")
#define PG8_BAR __builtin_amdgcn_s_barrier()
#define PG8_SCHED __builtin_amdgcn_sched_barrier(0)
    Unit cur, nxt; int ui = 0;
    if (!S.next(0, cur)) return;
    f32x4 acc[2][2][4][2];
#pragma unroll
    for (int a = 0; a < 2; ++a)
#pragma unroll
        for (int b = 0; b < 2; ++b)
#pragma unroll
            for (int m = 0; m < 4; ++m)
#pragma unroll
                for (int n = 0; n < 2; ++n) acc[a][b][m][n] = (f32x4){0.f, 0.f, 0.f, 0.f};
    bf16x8 At[4][2], B0[2][2], B1[2][2];
    const char* cA = (const char*)g.A + (size_t)cur.pm * tstepA + (size_t)cur.pn * gstep; const char* cB = (const char*)g.Bt + (size_t)cur.pn * tstepB;
    if constexpr (SP2) {
        PG8_STAGE(PG8_SB(0, 0), cB, voffB); PG8_STAGE(PG8_SB(0, 1), cB + hstepB, voffB); PG8_STAGE(PG8_SA(0, 0), cA, voffA); PG8_STAGE(PG8_SA(0, 1), cA + hstepA, voffA);
        if (wr == 1) PG8_BAR;
        PG8_WAIT_V(2); PG8_BAR;
        PG8_STAGE(PG8_SB(1, 0), cB + kstep, voffB); PG8_STAGE(PG8_SA(1, 0), cA + kstep, voffA); PG8_STAGE(PG8_SB(1, 1), cB + hstepB + kstep, voffB);
        PG8_WAIT_V(6); PG8_BAR;
    } else {
        PG8_STAGE(PG8_SB(0, 0), cB, voffB); PG8_STAGE(PG8_SA(0, 0), cA, voffA); PG8_STAGE(PG8_SB(0, 1), cB + hstepB, voffB); PG8_STAGE(PG8_SA(0, 1), cA + hstepA, voffA);
        if (wr == 1) PG8_BAR;
        PG8_WAIT_V(4); PG8_BAR;
        PG8_STAGE(PG8_SB(1, 0), cB + kstep, voffB); PG8_STAGE(PG8_SA(1, 0), cA + kstep, voffA); PG8_STAGE(PG8_SB(1, 1), cB + hstepB + kstep, voffB);
        PG8_WAIT_V(6); PG8_BAR;
    }
    for (;;) {
        const bool has_next = S.next(ui + 1, nxt);
        const char* nA = has_next ? (const char*)g.A + (size_t)nxt.pm * tstepA + (size_t)nxt.pn * gstep : cA; const char* nB = has_next ? (const char*)g.Bt + (size_t)nxt.pn * tstepB : cB;
        for (int t = 0; t < nt; t += 2) {
            const bool last = (t == nt - 2);
            const char* a1 = cA + (size_t)(t + 1) * kstep;
            const char* a2 = last ? nA : cA + (size_t)(t + 2) * kstep; const char* b2 = last ? nB : cB + (size_t)(t + 2) * kstep;
            const char* a3 = a2 + kstep; const char* b3 = b2 + kstep;
            if constexpr (SP2) {
            PG8_LDB(B0, 0, 0); PG8_LDB(B1, 0, 1); PG8_SCHED; PG8_LDA(At, 0, 0); PG8_STAGE(PG8_SA(1, 1), a1 + hstepA, voffA);
            PG8_WAIT_V(8); PG8_WAIT_L(0); PG8_BAR; PG8_MMA(0, 0, At, B0); PG8_MMA(0, 1, At, B1); PG8_BAR; PG8_SCHED;
            PG8_LDA(At, 0, 1); PG8_STAGE(PG8_SB(0, 0), b2, voffB); PG8_STAGE(PG8_SB(0, 1), b2 + hstepB, voffB); PG8_STAGE(PG8_SA(0, 0), a2, voffA);
            PG8_WAIT_V(8); PG8_WAIT_L(0); PG8_BAR; PG8_MMA(1, 0, At, B0); PG8_MMA(1, 1, At, B1); PG8_BAR; PG8_SCHED;
            PG8_LDB(B0, 1, 0); PG8_LDB(B1, 1, 1); PG8_SCHED; PG8_LDA(At, 1, 0); PG8_STAGE(PG8_SA(0, 1), a2 + hstepA, voffA);
            PG8_WAIT_V(8); PG8_WAIT_L(0); PG8_BAR; PG8_MMA(0, 0, At, B0); PG8_MMA(0, 1, At, B1); PG8_BAR; PG8_SCHED;
            PG8_LDA(At, 1, 1); PG8_STAGE(PG8_SB(1, 0), b3, voffB); PG8_STAGE(PG8_SB(1, 1), b3 + hstepB, voffB); PG8_STAGE(PG8_SA(1, 0), a3, voffA);
            PG8_WAIT_V(8); PG8_WAIT_L(0); PG8_BAR; PG8_MMA(1, 0, At, B0); PG8_MMA(1, 1, At, B1); PG8_BAR; PG8_SCHED;
            } else {
            PG8_LDB(B0, 0, 0); PG8_SCHED; PG8_LDA(At, 0, 0); PG8_STAGE(PG8_SA(1, 1), a1 + hstepA, voffA);
            PG8_WAIT_L(8); PG8_BAR; PG8_WAIT_L(0); PG8_MMA(0, 0, At, B0); PG8_BAR; PG8_SCHED;
            PG8_LDB(B1, 0, 1); PG8_STAGE(PG8_SB(0, 0), b2, voffB);
            PG8_BAR; PG8_WAIT_L(0); PG8_MMA(0, 1, At, B1); PG8_BAR;
            PG8_LDA(At, 0, 1); PG8_STAGE(PG8_SA(0, 0), a2, voffA);
            PG8_BAR; PG8_WAIT_L(0); PG8_MMA(1, 0, At, B0); PG8_BAR; PG8_SCHED;
            PG8_STAGE(PG8_SB(0, 1), b2 + hstepB, voffB);
            PG8_WAIT_V(6); PG8_BAR; PG8_MMA(1, 1, At, B1); PG8_BAR;
            PG8_LDB(B0, 1, 0); PG8_SCHED; PG8_LDA(At, 1, 0); PG8_STAGE(PG8_SA(0, 1), a2 + hstepA, voffA);
            PG8_WAIT_L(8); PG8_BAR; PG8_WAIT_L(0); PG8_MMA(0, 0, At, B0); PG8_BAR; PG8_SCHED;
            PG8_LDB(B1, 1, 1); PG8_STAGE(PG8_SB(1, 0), b3, voffB);
            PG8_BAR; PG8_WAIT_L(0); PG8_MMA(0, 1, At, B1); PG8_BAR;
            PG8_LDA(At, 1, 1); PG8_STAGE(PG8_SA(1, 0), a3, voffA);
            PG8_BAR; PG8_WAIT_L(0); PG8_MMA(1, 0, At, B0); PG8_BAR; PG8_SCHED;
            PG8_STAGE(PG8_SB(1, 1), b3 + hstepB, voffB);
            PG8_WAIT_V(6); PG8_BAR; PG8_MMA(1, 1, At, B1); PG8_BAR;
            }
        }
        if constexpr (ALIGN_EPI) { if (wr == 0) PG8_BAR; }
        if constexpr (!Epi::AFTER_DRAIN) { E(acc, cur, wr, wc, fr, fq); }
        if (!has_next) break;
#pragma unroll
        for (int a = 0; a < 2; ++a)
#pragma unroll
            for (int b = 0; b < 2; ++b)
#pragma unroll
                for (int m = 0; m < 4; ++m)
#pragma unroll
                    for (int n = 0; n < 2; ++n) acc[a][b][m][n] = (f32x4){0.f, 0.f, 0.f, 0.f};
        cur = nxt; cA = nA; cB = nB; ++ui;
        if constexpr (ALIGN_EPI) { if (wr == 1) PG8_BAR; }
    }
    PG8_WAIT_V(0);
    if constexpr (!ALIGN_EPI) { if (wr == 0) PG8_BAR; }
    PG8_BAR;
    if constexpr (Epi::AFTER_DRAIN) { E.fused(acc, cur, wr, wc, fr, fq, lds, wid, lane); }
#undef PG8_SA
#undef PG8_SB
#undef PG8_STAGE
#undef PG8_LDA
#undef PG8_LDB
#undef PG8_MMA
#undef PG8_WAIT_V
#undef PG8_WAIT_L
#undef PG8_BAR
#undef PG8_SCHED
}
}

#define XB_TMO      128
#define XB_XCNT(j)  (256  + 64 * (j))
#define XB_XSUB(j)  (1280 + 64 * (j))
#define XB_XGEN(j)  (2304 + 64 * (j))
#define XB_TOP      3328
#define XB_TOPGEN   3392
#define XCD_BAR_WORDS 3456
#define XB_SPIN_CAP (1u << 18)
static_assert((CW_BAR + XCD_BAR_WORDS) * 4 <= (int)CTL_ZERO_BYTES, "barrier words inside the memset region");

__device__ __forceinline__ unsigned xb_ld(unsigned* p)              { return __hip_atomic_load(p, __ATOMIC_RELAXED, __HIP_MEMORY_SCOPE_AGENT); }
__device__ __forceinline__ unsigned xb_add(unsigned* p, unsigned v) { return __hip_atomic_fetch_add(p, v, __ATOMIC_RELAXED, __HIP_MEMORY_SCOPE_AGENT); }
__device__ __forceinline__ unsigned xb_xcc_id() { return (unsigned)__builtin_amdgcn_s_getreg((3 << 11) | 20) & 0xFu; }
#define XB_SPIN(cond, bar) do { unsigned _sp = 0; while (cond) { __builtin_amdgcn_s_sleep(1); \
    if ((++_sp & 255u) == 0u) { if (xb_ld(&(bar)[XB_TMO])) break; if (_sp > XB_SPIN_CAP) { atomicAdd(&(bar)[XB_TMO], 1u); break; } } } } while (0)

struct XcdBarrier { unsigned* bar; unsigned x; volatile LAS unsigned* st; };
__device__ __forceinline__ XcdBarrier xcd_barrier_post(unsigned* bar, volatile LAS unsigned* st) {
    XcdBarrier b; b.bar = bar; b.x = xb_xcc_id(); b.st = st;
    if (threadIdx.x == 0) (void)xb_add(&bar[XB_XCNT(b.x)], 1u);
    return b;
}
__device__ __forceinline__ void xcd_barrier_complete(unsigned* bar, unsigned x, unsigned& nloc, unsigned& nx) {
    const unsigned G = gridDim.x * gridDim.y * gridDim.z;
    unsigned sum, cnt, mine, sp = 0u;
    for (;;) {
        sum = 0u; cnt = 0u; mine = 0u;
#pragma unroll
        for (unsigned j = 0; j < 16; ++j) { const unsigned c = xb_ld(&bar[XB_XCNT(j)]); sum += c; cnt += (c > 0u) ? 1u : 0u; mine = (j == x) ? c : mine; }
        if (sum == G) break;
        __builtin_amdgcn_s_sleep(1);
        if ((++sp & 255u) == 0u) { if (xb_ld(&bar[XB_TMO])) break; if (sp > XB_SPIN_CAP) { atomicAdd(&bar[XB_TMO], 1u); break; } }
    }
    nloc = mine > 0u ? mine : 1u; nx = cnt > 0u ? cnt : 1u;
}
__device__ __forceinline__ void xcd_barrier(const XcdBarrier& b) {
    asm volatile("s_waitcnt vmcnt(0)" ::: "memory");
    __syncthreads();
    if (threadIdx.x == 0) {
        unsigned* bar = b.bar;
        __builtin_amdgcn_s_waitcnt(0);
        unsigned nloc = b.st[0], nx = b.st[1];
        if (nloc == 0u) { xcd_barrier_complete(bar, b.x, nloc, nx); b.st[0] = nloc; b.st[1] = nx; }
        const unsigned old = xb_add(&bar[XB_XSUB(b.x)], 1u);
        const unsigned gen = old / nloc;
        if (old + 1u == (gen + 1u) * nloc) {
            __builtin_amdgcn_fence(__ATOMIC_RELEASE, "agent");
            asm volatile("s_waitcnt vmcnt(0)" ::: "memory");
            const unsigned og = xb_add(&bar[XB_TOP], 1u);
            const unsigned tg = og / nx;
            if (og + 1u == (tg + 1u) * nx) xb_add(&bar[XB_TOPGEN], 1u);
            else XB_SPIN(xb_ld(&bar[XB_TOPGEN]) == tg, bar);
            __builtin_amdgcn_fence(__ATOMIC_ACQUIRE, "agent");
            xb_add(&bar[XB_XGEN(b.x)], 1u);
            asm volatile("s_waitcnt vmcnt(0)" ::: "memory");
        } else {
            XB_SPIN(xb_ld(&bar[XB_XGEN(b.x)]) == gen, bar);
            __builtin_amdgcn_fence(__ATOMIC_ACQUIRE, "agent");
            asm volatile("s_waitcnt vmcnt(0)" ::: "memory");
        }
    }
    __syncthreads();
}

struct Args { const float* in[13]; float* out; unsigned char* ws; int ph_lo, ph_hi; };
struct Frame {
    LAS unsigned char* lds;
    int tid, lane, wave, vcu, G;
    const float* in[13];
    float* H;
    unsigned char* ws;
};

__device__ __forceinline__ void tr_item(const float* W, int srcN, int K, int k0, int n0, const float* gk, float sn, bf16_t* WT, int drow0, LAS float* scr, int lane) {
#pragma unroll 8
    for (int i = 0; i < 32; ++i) { const int kk = 2 * i + (lane >> 5); const float gs = gk ? gk[k0 + kk] : 1.0f;
        scr[kk * 33 + (lane & 31)] = W[(size_t)(k0 + kk) * srcN + n0 + (lane & 31)] * (gs * sn); }
    LDS_WAIT(); asm volatile("" ::: "memory");
    const int c = lane & 7;
#pragma unroll
    for (int j = 0; j < 4; ++j) { const int n = (lane >> 3) + 8 * j; const LAS float* s = scr + (8 * c) * 33 + n;
        u32x4 o; o.x = cvt_pk_bf16(s[0 * 33], s[1 * 33]); o.y = cvt_pk_bf16(s[2 * 33], s[3 * 33]); o.z = cvt_pk_bf16(s[4 * 33], s[5 * 33]); o.w = cvt_pk_bf16(s[6 * 33], s[7 * 33]);
        *(u32x4*)(WT + (size_t)(drow0 + n) * K + k0 + 8 * c) = o; }
    LDS_WAIT(); asm volatile("" ::: "memory");
}
__device__ __forceinline__ void p0_prologue(Frame& F) {
    LAS float* scr = (LAS float*)(F.lds + F.wave * 16384);
    const int gw = F.vcu * NWAVES + F.wave, NGW = F.G * NWAVES, lane = F.lane, ln = lane & 31;
    const float* pool_norm = F.in[1]; const float* pool_w = F.in[2]; const float* pool_scale = F.in[3];
    const float* mlstm_norm = F.in[4]; const float* w_in = F.in[5]; const float* head_norm = F.in[7]; const float* w_out = F.in[8];
    const float* ffn_norm = F.in[9]; const float* ffn_w_in = F.in[10]; const float* ffn_w_out = F.in[11];
    bf16_t* WPOOL = (bf16_t*)(F.ws + WS_WPOOL); bf16_t* WIN = (bf16_t*)(F.ws + WS_WIN); bf16_t* WOUT = (bf16_t*)(F.ws + WS_WOUT);
    bf16_t* WF1 = (bf16_t*)(F.ws + WS_WF1); bf16_t* WF2 = (bf16_t*)(F.ws + WS_WF2);
    constexpr int I_POOL = 8 * 32, I_IN = 2 * 1536, I_OUT = 2 * 512, I_F1 = 4 * 2816, I_F2 = 4 * 1408;
    constexpr int NITEMS = I_POOL + I_IN + I_OUT + I_F1 + I_F2;
    for (int it = gw; it < NITEMS; it += NGW) {
        int r = it;
        if (r < I_F1) { const int i = r / 2816, rr = r % 2816, kb = rr / 176, nb = rr % 176, n0 = 32 * nb, jh = n0 % DFF, isup = n0 / DFF;
            tr_item(ffn_w_in + (size_t)i * D * 2 * DFF, 2 * DFF, D, 64 * kb, n0, ffn_norm + i * D, 1.0f, WF1 + (size_t)i * 2 * DFF * D, (jh / 128) * 256 + isup * 128 + (jh % 128), scr, lane); continue; } r -= I_F1;
        if (r < I_F2) { const int i = r / 1408, rr = r % 1408, kb = rr / 32, nb = rr % 32;
            tr_item(ffn_w_out + (size_t)i * DFF * D, D, DFF, 64 * kb, 32 * nb, nullptr, 1.0f, WF2 + (size_t)i * D * DFF, 32 * nb, scr, lane); continue; } r -= I_F2;
        if (r < I_IN) { const int j = r / 1536, rr = r % 1536, kb = rr / 96, nb = rr % 96, n0 = 32 * nb;
            tr_item(w_in + (size_t)j * D * INW, INW, D, 64 * kb, n0, mlstm_norm + j * D, (n0 + ln < NH * DQK) ? 0.08838834764831845f : 1.0f, WIN + (size_t)j * INW_MAIN * D, n0, scr, lane); continue; } r -= I_IN;
        if (r < I_OUT) { const int j = r / 512, rr = r % 512, kb = rr / 32, nb = rr % 32;
            tr_item(w_out + (size_t)j * D * D, D, D, 64 * kb, 32 * nb, head_norm + j * D, 1.0f, WOUT + (size_t)j * D * D, 32 * nb, scr, lane); continue; } r -= I_OUT;
        { const int mat = r / 32, rr = r % 32, kb = rr / 8, nb = rr % 8, j = mat / 4, g = mat % 4, n0 = 32 * nb;
            tr_item(pool_w + (size_t)mat * 65536, 256, 256, 64 * kb, n0, pool_norm + j * D + g * 256, pool_scale[j * D + g * 256 + n0 + ln], WPOOL + (size_t)j * D * 256, g * 256 + n0, scr, lane); }
    }
    { float* WG = (float*)(F.ws + WS_WG); const int gt = F.vcu * NTHREADS + F.tid;
      if (gt < 2 * 8 * D) { const int j = gt / (8 * D), n8 = (gt / D) % 8, k = gt % D; WG[gt] = w_in[(size_t)j * D * INW + (size_t)k * INW + INW_MAIN + n8] * mlstm_norm[j * D + k]; } }
    { const float* x = F.in[0]; float* SSQ = (float*)(F.ws + WS_SSQ);
      for (int m = gw; m < M; m += NGW) { const f32x4* xr = (const f32x4*)(x + (size_t)m * D) + lane; float s = 0.f;
#pragma unroll
          for (int j = 0; j < 4; ++j) { const f32x4 v = xr[64 * j]; s += (v.x * v.x + v.y * v.y) + (v.z * v.z + v.w * v.w); }
          s = wave_sum(s); if (lane == 0) *(f32x4*)(SSQ + (size_t)m * 4) = (f32x4){s, 0.f, 0.f, 0.f}; } }
}

__device__ __forceinline__ void pool_prep(Frame& F, const float* h) {
    const float* SSQ = (const float*)(F.ws + WS_SSQ); bf16_t* POOLED = (bf16_t*)(F.ws + WS_POOLED);
    LAS float* rinv = (LAS float*)F.lds;
    const int tid = F.tid, c = 2 * tid, grp = tid >> 7, win = 2 << grp;
    for (int tile = blockIdx.x; tile < M / 64; tile += F.G) {
        const int r0 = tile * 64, tp0 = r0 % SEQ;
        __syncthreads();
        if (tid < 80) { const int tp = tp0 - 16 + tid; rinv[tid] = (tp >= 0) ? rinv_of(*(const f32x4*)(SSQ + (size_t)(r0 - 16 + tid) * 4)) : 0.f; }
        __syncthreads();
        f32x2 S = {0.f, 0.f};
        for (int u = -win; u < 0; ++u) if (tp0 + u >= 0) { const f32x2 v = *(const f32x2*)(h + (size_t)(r0 + u) * D + c); const float ri = rinv[16 + u]; S.x += v.x * ri; S.y += v.y * ri; }
#pragma unroll 4
        for (int t = 0; t < 64; ++t) {
            const f32x2 v = *(const f32x2*)(h + (size_t)(r0 + t) * D + c); const float ri = rinv[16 + t];
            const float x0 = v.x * ri, x1 = v.y * ri; S.x += x0; S.y += x1;
            const int tp = tp0 + t;
            if (tp - win >= 0) { const f32x2 o = *(const f32x2*)(h + (size_t)(r0 + t - win) * D + c); const float ro = rinv[16 + t - win]; S.x -= o.x * ro; S.y -= o.y * ro; }
            const float ic = 1.0f / (float)((tp + 1 < win) ? (tp + 1) : win);
            *(unsigned*)(POOLED + (size_t)(r0 + t) * D + c) = cvt_pk_bf16(S.x * ic - x0, S.y * ic - x1);
        }
    }
}

__device__ __forceinline__ void gates_part(Frame& F, int j) {
    const float* WG = (const float*)(F.ws + WS_WG) + (size_t)j * 8 * D; const float* SSQ = (const float*)(F.ws + WS_SSQ);
    const float* gbias = F.in[6] + j * 8; float* GI = (float*)(F.ws + WS_GI); float* GF = (float*)(F.ws + WS_GF);
    const int lane = F.lane;
    for (int rb = blockIdx.x; rb < M / 64; rb += F.G) {
        for (int rr = 0; rr < 8; ++rr) {
            const int row = rb * 64 + F.wave * 8 + rr;
            f32x4 hv[4];
#pragma unroll
            for (int q = 0; q < 4; ++q) hv[q] = *(const f32x4*)(F.H + (size_t)row * D + 256 * q + 4 * lane);
            float myv = 0.f;
#pragma unroll
            for (int n = 0; n < 8; ++n) { float a = 0.f;
#pragma unroll
                for (int q = 0; q < 4; ++q) { const f32x4 w = *(const f32x4*)(WG + n * D + 256 * q + 4 * lane); a += (hv[q].x * w.x + hv[q].y * w.y) + (hv[q].z * w.z + hv[q].w * w.w); }
                a = wave_sum(a); if (lane == n) myv = a; }
            if (lane < 8) {
                const float ri = rinv_of(*(const f32x4*)(SSQ + (size_t)row * 4));
                const float val = myv * ri + gbias[lane];
                const int hh = lane & 3, bb = row / SEQ, t = row % SEQ; const size_t o = (size_t)(bb * NH + hh) * SEQ + t;
                if (lane < 4) GI[o] = val;
                else GF[o] = (val > 0.f) ? -log1pf(expf(-val)) : (val - log1pf(expf(val)));
            }
        }
    }
}

__device__ __forceinline__ float wave_incl_add(float v, int lane) {
#pragma unroll
    for (int o = 1; o < 64; o <<= 1) { const float t = __shfl_up(v, o); if (lane >= o) v += t; }
    return v;
}
__device__ __forceinline__ float wave_incl_max(float v, int lane) {
#pragma unroll
    for (int o = 1; o < 64; o <<= 1) { const float t = __shfl_up(v, o); if (lane >= o) v = fmaxf(v, t); }
    return v;
}
__device__ __forceinline__ bf16x8 pack8(const float (&v)[8]) {
    u32x4 w; w.x = cvt_pk_bf16(v[0], v[1]); w.y = cvt_pk_bf16(v[2], v[3]); w.z = cvt_pk_bf16(v[4], v[5]); w.w = cvt_pk_bf16(v[6], v[7]);
    return __builtin_bit_cast(bf16x8, w);
}
typedef __amdgpu_buffer_rsrc_t rsrc_t;
__device__ __forceinline__ rsrc_t mk_rsrc(const void* p) { return __builtin_amdgcn_make_buffer_rsrc((void*)p, 0, 0x7fffffff, 0x00020000); }
__device__ __forceinline__ bf16x8 bld128(rsrc_t r, unsigned voff, unsigned soff) { return __builtin_bit_cast(bf16x8, __builtin_amdgcn_raw_buffer_load_b128(r, voff, soff, 0)); }
__device__ __forceinline__ u32x2 bld64(rsrc_t r, unsigned voff, unsigned soff) { return __builtin_amdgcn_raw_buffer_load_b64(r, voff, soff, 0); }
__device__ __forceinline__ void bst64(rsrc_t r, u32x2 v, unsigned voff, unsigned soff) { __builtin_amdgcn_raw_buffer_store_b64(v, r, voff, soff, 0); }

__device__ __forceinline__ void scan_phase(Frame& F) {
    const float* GI = (const float*)(F.ws + WS_GI); const float* GF = (const float*)(F.ws + WS_GF);
    float* TA = (float*)(F.ws + WS_TA); float* TM = (float*)(F.ws + WS_TM); float* TB = (float*)(F.ws + WS_TB); float* MPREV = (float*)(F.ws + WS_MPREV);
    float* NST = (float*)(F.ws + WS_NST);
    const rsrc_t rKT = mk_rsrc(F.ws + WS_KT), rVT = mk_rsrc(F.ws + WS_VT), rCST = mk_rsrc(F.ws + WS_CST);
    LAS float* TAs = (LAS float*)F.lds;
    LAS float* CMs = TAs + 4096;
    LAS float* BCs = CMs + 4096; LAS float* ACs = BCs + 16; LAS float* MPs = ACs + 16; LAS float* MEs = MPs + 16;
    const int lane = F.lane, wid = F.wave, tid = F.tid, lr = lane & 15, lg = lane >> 4;
    for (int unit = F.vcu; unit < NSTREAM * 16; unit += F.G) {
        const int stream = unit >> 4, j = unit & 15;
        __syncthreads();
        for (int cc = 0; cc < 2; ++cc) {
            const int c = wid + 8 * cc; const size_t base = (size_t)stream * SEQ + c * LC + 4 * lane;
            const f32x4 f = *(const f32x4*)(GF + base), ii = *(const f32x4*)(GI + base);
            const float p0 = f.x, p1 = p0 + f.y, p2 = p1 + f.z, p3 = p2 + f.w;
            const float incl = wave_incl_add(p3, lane), excl = incl - p3;
            const float b0 = excl + p0, b1 = excl + p1, b2 = excl + p2, b3 = excl + p3;
            const float a0 = ii.x - b0, a1 = ii.y - b1, a2 = ii.z - b2, a3 = ii.w - b3;
            const float q0 = a0, q1 = fmaxf(q0, a1), q2 = fmaxf(q1, a2), q3 = fmaxf(q2, a3);
            const float im = wave_incl_max(q3, lane); float exm = __shfl_up(im, 1); if (lane == 0) exm = -INFINITY;
            const f32x4 cm = {fmaxf(exm, q0), fmaxf(exm, q1), fmaxf(exm, q2), fmaxf(exm, q3)};
            *(LAS f32x4*)(TAs + c * LC + 4 * lane) = (f32x4){a0, a1, a2, a3};
            *(LAS f32x4*)(CMs + c * LC + 4 * lane) = cm;
            if (j == 0) *(f32x4*)(TB + base) = (f32x4){b0, b1, b2, b3};
            if (lane == 63) { BCs[c] = b3; ACs[c] = cm.w; }
        }
        __syncthreads();
        if (tid == 0) { float m = 0.f; for (int c = 0; c < NCH; ++c) { MPs[c] = m; const float me = fmaxf(m, ACs[c]); MEs[c] = me; m = BCs[c] + me; } }
        __syncthreads();
        for (int s2 = tid; s2 < SEQ; s2 += NTHREADS) { const float a = TAs[s2]; const int c = s2 >> 8;
            if (j == 0) { TA[(size_t)stream * SEQ + s2] = a; TM[(size_t)stream * SEQ + s2] = fmaxf(MPs[c], CMs[s2]); }
            TAs[s2] = __expf(a - MEs[c]); }
        if (j == 0 && tid < NCH) MPREV[stream * NCH + tid] = MPs[tid];
        __syncthreads();
        f32x4 acc = {0.f, 0.f, 0.f, 0.f}, accn = {0.f, 0.f, 0.f, 0.f};
        const unsigned voff = (unsigned)(lr * (SEQ * 2) + lg * 16);
        const unsigned sK0 = (unsigned)((stream * DQK + 16 * wid) * SEQ * 2), sV0 = (unsigned)((stream * DV + 16 * j) * SEQ * 2);
        const unsigned voffc = (unsigned)(lr * (DQK * 2) + lg * 8);
        bf16x8 ones; { const short o1 = (short)0x3F80;
#pragma unroll
            for (int e = 0; e < 8; ++e) ones[e] = o1; }
#pragma unroll 1
        for (int c = 0; c < NCH; ++c) {
            { u32x2 w; w.x = cvt_pk_bf16(acc[0], acc[1]); w.y = cvt_pk_bf16(acc[2], acc[3]);
              bst64(rCST, w, voffc, (unsigned)((((stream * NCH + c) * DV + 16 * j) * DQK + 16 * wid) * 2));
              if (j == 0 && lr == 0) *(f32x4*)(NST + (size_t)(stream * NCH + c) * DQK + 16 * wid + 4 * lg) = accn; }
            if (c == NCH - 1) break;
            const float decay = __expf(MPs[c] - MEs[c]);
            acc *= decay; accn *= decay;
#pragma unroll
            for (int ks = 0; ks < 8; ++ks) {
                const int s0 = c * LC + ks * 32;
                const bf16x8 kf = bld128(rKT, voff, sK0 + (unsigned)(s0 * 2));
                const bf16x8 vf = bld128(rVT, voff, sV0 + (unsigned)(s0 * 2));
                const f32x4 w0 = *(const LAS f32x4*)(TAs + s0 + 8 * lg), w1 = *(const LAS f32x4*)(TAs + s0 + 8 * lg + 4);
                float sc[8];
#pragma unroll
                for (int e = 0; e < 4; ++e) { sc[e] = bf2f((unsigned short)kf[e]) * w0[e]; sc[4 + e] = bf2f((unsigned short)kf[4 + e]) * w1[e]; }
                const bf16x8 af = pack8(sc);
                acc = __builtin_amdgcn_mfma_f32_16x16x32_bf16(af, vf, acc, 0, 0, 0);
                accn = __builtin_amdgcn_mfma_f32_16x16x32_bf16(af, ones, accn, 0, 0, 0);
            }
        }
    }
}

__device__ __forceinline__ void out_phase(Frame& F) {
    const float* TA = (const float*)(F.ws + WS_TA); const float* TM = (const float*)(F.ws + WS_TM); const float* TB = (const float*)(F.ws + WS_TB);
    const float* MPREV = (const float*)(F.ws + WS_MPREV); const float* NST = (const float*)(F.ws + WS_NST);
    const rsrc_t rQKO = mk_rsrc(F.ws + WS_QKO), rVT = mk_rsrc(F.ws + WS_VT), rCST = mk_rsrc(F.ws + WS_CST), rHG = mk_rsrc(F.ws + WS_HG);
    LAS float* As = (LAS float*)F.lds; LAS float* Ms = As + LC; LAS float* Bs = Ms + LC;
    const int lane = F.lane, wid = F.wave, tid = F.tid, lr = lane & 15, lg = lane >> 4;
    const unsigned voq = (unsigned)(lr * 4096 + lg * 16), voc = (unsigned)(lr * 256 + lg * 16), vov = (unsigned)(lr * 8192 + lg * 8);
    const unsigned voo = (unsigned)(lr * 4096 + lg * 8), vog = (unsigned)(lr * 2048 + lg * 8);
    for (int unit = blockIdx.x; unit < NSTREAM * NCH; unit += F.G) {
        const int stream = unit >> 4, c = unit & 15, bb = stream >> 2, hh = stream & 3;
        const int rowbase = bb * SEQ + c * LC;
        __syncthreads();
        if (tid < LC) { const size_t o = (size_t)stream * SEQ + c * LC + tid; As[tid] = TA[o]; Ms[tid] = TM[o]; Bs[tid] = TB[o]; }
        __syncthreads();
        const float* nst = NST + (size_t)(stream * NCH + c) * DQK;
        const float mprev = MPREV[stream * NCH + c];
#if defined(DBG) && DBG > 0
        {
            const bf16_t* QKOp = (const bf16_t*)(F.ws + WS_QKO); const bf16_t* VTp = (const bf16_t*)(F.ws + WS_VT); const bf16_t* KTp = (const bf16_t*)(F.ws + WS_KT);
            const bf16_t* CSTp = (const bf16_t*)(F.ws + WS_CST); bf16_t* HGp = (bf16_t*)(F.ws + WS_HG);
            if (tid < LC) { const int t = tid; const size_t row = (size_t)rowbase + t;
                for (int v = 0; v < DV; ++v) { float val;
#if DBG == 1
                    val = bf2f(QKOp[row * 2048 + hh * DQK + (v & 127)]) + bf2f(QKOp[row * 2048 + 512 + hh * DQK + (v & 127)]) + bf2f(QKOp[row * 2048 + 1024 + hh * DV + v])
                        + bf2f(VTp[((size_t)stream * DV + v) * SEQ + c * LC + t]) + bf2f(KTp[((size_t)stream * DQK + (v & 127)) * SEQ + c * LC + t]);
#else
                    val = bf2f(CSTp[((size_t)(stream * NCH + c) * DV + v) * DQK + (t & 127)]) + nst[t & 127] + As[t] + Ms[t] + Bs[t] + mprev;
#endif
                    HGp[row * D + hh * DV + v] = (bf16_t)(cvt_pk_bf16(val, 0.f) & 0xffffu); } }
            continue;
        }
#endif
        const unsigned sC = (unsigned)((stream * NCH + c) * DV * DQK * 2);
#pragma unroll 1
        for (int rnd = 0; rnd < 2; ++rnd) {
            const int tb = rnd ? (15 - wid) : wid;
            const int t = 16 * tb + lr;
            const float Mt = Ms[t], inter = __expf(mprev - Mt), floorv = __expf(-(Bs[t] + Mt));
            const unsigned sQ = (unsigned)(((rowbase + 16 * tb) * 2048 + hh * DQK) * 2);
            bf16x8 qf[4];
#pragma unroll
            for (int kq = 0; kq < 4; ++kq) qf[kq] = bld128(rQKO, voq, sQ + 64 * kq);
            f32x4 acc[16];
#pragma unroll
            for (int vg = 0; vg < 4; ++vg) {
                bf16x8 a[4][4];
#pragma unroll
                for (int v = 0; v < 4; ++v)
#pragma unroll
                    for (int kq = 0; kq < 4; ++kq) a[v][kq] = bld128(rCST, voc, sC + (unsigned)(16 * (4 * vg + v) * DQK * 2 + 64 * kq));
#pragma unroll
                for (int v = 0; v < 4; ++v) { acc[4 * vg + v] = (f32x4){0.f, 0.f, 0.f, 0.f};
#pragma unroll
                    for (int kq = 0; kq < 4; ++kq) acc[4 * vg + v] = __builtin_amdgcn_mfma_f32_16x16x32_bf16(a[v][kq], qf[kq], acc[4 * vg + v], 0, 0, 0); }
            }
            f32x4 accn = {0.f, 0.f, 0.f, 0.f};
#pragma unroll
            for (int kq = 0; kq < 4; ++kq) { float nv[8];
                const f32x4 n0 = *(const f32x4*)(nst + 32 * kq + 8 * lg), n1 = *(const f32x4*)(nst + 32 * kq + 8 * lg + 4);
#pragma unroll
                for (int e = 0; e < 4; ++e) { nv[e] = (lr == 0) ? n0[e] : 0.f; nv[4 + e] = (lr == 0) ? n1[e] : 0.f; }
                accn = __builtin_amdgcn_mfma_f32_16x16x32_bf16(pack8(nv), qf[kq], accn, 0, 0, 0); }
            const float qn = __shfl(accn[0], lr);
#pragma unroll
            for (int vb = 0; vb < 16; ++vb) acc[vb] *= inter;
            float dsum = 0.f;
            const int nsteps = (tb >> 1) + 1;
#pragma unroll 1
            for (int ks = 0; ks < nsteps; ++ks) {
                float p[8];
#pragma unroll
                for (int mb = 0; mb < 2; ++mb) { f32x4 sa = {0.f, 0.f, 0.f, 0.f};
                    const unsigned sK = (unsigned)(((rowbase + 32 * ks + 16 * mb) * 2048 + NH * DQK + hh * DQK) * 2);
#pragma unroll
                    for (int kq = 0; kq < 4; ++kq) sa = __builtin_amdgcn_mfma_f32_16x16x32_bf16(bld128(rQKO, voq, sK + 64 * kq), qf[kq], sa, 0, 0, 0);
                    const int sb = 32 * ks + 16 * mb + 4 * lg;
                    const f32x4 av = *(const LAS f32x4*)(As + sb);
#pragma unroll
                    for (int r = 0; r < 4; ++r) { const float d = (sb + r <= t) ? __expf(av[r] - Mt) : 0.f; const float pv = sa[r] * d; p[mb * 4 + r] = pv; dsum += pv; } }
                const bf16x8 pf = pack8(p);
                const unsigned sV = (unsigned)((stream * DV * SEQ + c * LC + 32 * ks) * 2);
#pragma unroll
                for (int vb = 0; vb < 16; ++vb) {
                    const u32x2 lo = bld64(rVT, vov, sV + (unsigned)(16 * vb * SEQ * 2)), hi = bld64(rVT, vov, sV + (unsigned)(16 * vb * SEQ * 2 + 32));
                    const u32x4 av4 = {lo.x, lo.y, hi.x, hi.y};
                    acc[vb] = __builtin_amdgcn_mfma_f32_16x16x32_bf16(__builtin_bit_cast(bf16x8, av4), pf, acc[vb], 0, 0, 0);
                }
            }
            dsum += __shfl_xor(dsum, 16); dsum += __shfl_xor(dsum, 32);
            const float den = inter * qn + dsum;
            const float rden = 1.0f / fmaxf(fabsf(den), floorv);
            float ss = 0.f;
#pragma unroll
            for (int vb = 0; vb < 16; ++vb) { acc[vb] *= rden; ss += (acc[vb][0] * acc[vb][0] + acc[vb][1] * acc[vb][1]) + (acc[vb][2] * acc[vb][2] + acc[vb][3] * acc[vb][3]); }
            ss += __shfl_xor(ss, 16); ss += __shfl_xor(ss, 32);
            const float rn = 1.0f / sqrtf(ss * (1.0f / DV) + EPS);
            const unsigned sO = (unsigned)(((rowbase + 16 * tb) * 2048 + 2 * NH * DQK + hh * DV) * 2), sG = (unsigned)(((rowbase + 16 * tb) * D + hh * DV) * 2);
#pragma unroll
            for (int vb = 0; vb < 16; ++vb) {
                const u32x2 ov = bld64(rQKO, voo, sO + 32 * vb);
                const float o0 = bflo(ov.x), o1 = bfhi(ov.x), o2 = bflo(ov.y), o3 = bfhi(ov.y);
                const float g0 = acc[vb][0] * rn / (1.0f + __expf(-o0)), g1 = acc[vb][1] * rn / (1.0f + __expf(-o1));
                const float g2 = acc[vb][2] * rn / (1.0f + __expf(-o2)), g3 = acc[vb][3] * rn / (1.0f + __expf(-o3));
                u32x2 w; w.x = cvt_pk_bf16(g0, g1); w.y = cvt_pk_bf16(g2, g3);
                bst64(rHG, w, vog, sG + 32 * vb);
            }
        }
    }
}

__device__ __forceinline__ void final_norm(Frame& F) {
    const float* SSQ = (const float*)(F.ws + WS_SSQ); const float* g = F.in[12];
    const int gw = blockIdx.x * NWAVES + F.wave, NGW = F.G * NWAVES, lane = F.lane;
    f32x4 gv[4];
#pragma unroll
    for (int j = 0; j < 4; ++j) gv[j] = *(const f32x4*)(g + 256 * j + 4 * lane);
    for (int m = gw; m < M; m += NGW) {
        const float ri = rinv_of(*(const f32x4*)(SSQ + (size_t)m * 4));
        f32x4* xr = (f32x4*)(F.H + (size_t)m * D) + lane;
#pragma unroll
        for (int j = 0; j < 4; ++j) { const f32x4 v = xr[64 * j]; xr[64 * j] = v * ri * gv[j]; }
    }
}

#define CAS __attribute__((address_space(4)))
__global__ void __launch_bounds__(NTHREADS, 2) mk_fwd(Args args_unused) {
    extern __shared__ __attribute__((aligned(16))) unsigned char lds_raw[];
    {
        LAS unsigned char* l0 = (LAS unsigned char*)lds_raw;
        for (int u = threadIdx.x; u < (LDS_BYTES - LDSCTL_OFF) / 4; u += NTHREADS) ((LAS unsigned*)(l0 + LDSCTL_OFF))[u] = 0u;
        __syncthreads();
    }
    int lo, hi;
    { const CAS Args* ap0 = (const CAS Args*)__builtin_amdgcn_kernarg_segment_ptr(); lo = ap0->ph_lo; hi = ap0->ph_hi; }
    XcdBarrier bar; bar.bar = nullptr; bar.x = 0; bar.st = nullptr;
    if (hi - lo > 1) { const CAS Args* ap0 = (const CAS Args*)__builtin_amdgcn_kernarg_segment_ptr();
        bar = xcd_barrier_post((unsigned*)(ap0->ws + WS_CTL) + CW_BAR, (volatile LAS unsigned*)((LAS unsigned char*)lds_raw + MISC_OFF) + 8); }
#pragma unroll 1
    for (int ph = lo; ph < hi; ++ph) {
        unsigned long long apv = (unsigned long long)__builtin_amdgcn_kernarg_segment_ptr(); asm volatile("" : "+s"(apv));
        const CAS Args* ap = (const CAS Args*)apv;
        int tidv = threadIdx.x; asm volatile("" : "+v"(tidv));
        Frame F;
        F.lds = (LAS unsigned char*)lds_raw;
        F.tid = tidv; F.lane = F.tid & 63; F.wave = __builtin_amdgcn_readfirstlane(F.tid >> 6);
        F.G = gridDim.x; { const int bx = blockIdx.x; F.vcu = (F.G % 8 == 0) ? (bx % 8) * (F.G / 8) + bx / 8 : bx; }
#pragma unroll
        for (int i = 0; i < 13; ++i) F.in[i] = ap->in[i];
        F.H = ap->out; F.ws = ap->ws;
        struct { const float* in0; unsigned char* ws; } args; args.in0 = F.in[0]; args.ws = F.ws;
        bf16_t* HB = (bf16_t*)(args.ws + WS_HB); float* SSQ = (float*)(args.ws + WS_SSQ);
        int layer = 0, pos = 0, kind;
        if (ph == 0) kind = 0;
        else if (ph == NPHASES - 1) kind = 8;
        else {
            const int q = ph - 1;
            if (q < 4) { layer = 0; pos = q; } else if (q < 10) { layer = 1; pos = q - 4; } else if (q < 14) { layer = 2; pos = q - 10; } else { layer = 3; pos = q - 14; }
            if ((layer & 1) == 0) kind = (pos == 0) ? 1 : (pos == 1) ? 2 : (pos == 2) ? 3 : 4;
            else kind = (pos == 0) ? 5 : (pos == 1) ? 6 : (pos == 2) ? 7 : (pos == 3) ? 2 : (pos == 4) ? 3 : 4;
        }
        const int jl = layer >> 1;
        if (kind == 0) { if (PH_ON(0)) p0_prologue(F); }
        else if (kind == 1) { if (PH_ON(1)) pool_prep(F, layer == 0 ? args.in0 : F.H); }
        else if (kind == 2 || kind == 4) {
            pg8::Gemm g; pg8::StaticOrder S; S.init(M, D, F.G, (int)blockIdx.x);
            const float* base = F.H;
            if (kind == 4) { g.A = (const bf16_t*)(args.ws + WS_HID); g.Bt = (const bf16_t*)(args.ws + WS_WF2) + (size_t)layer * D * DFF; g.lda = DFF; g.K = DFF; g.grouped = 0; }
            else if ((layer & 1) == 0) { g.A = (const bf16_t*)(args.ws + WS_POOLED); g.Bt = (const bf16_t*)(args.ws + WS_WPOOL) + (size_t)jl * D * 256; g.lda = D; g.K = 256; g.grouped = 1; if (layer == 0) base = args.in0; }
            else { g.A = (const bf16_t*)(args.ws + WS_HG); g.Bt = (const bf16_t*)(args.ws + WS_WOUT) + (size_t)jl * D * D; g.lda = D; g.K = D; g.grouped = 0; }
            pg8::EpiResid E{base, F.H, HB, SSQ};
            if (PH_ON(2)) pg8::gemm_phase<pg8::EpiResid, false, true>(F.lds, g, S, E, F.tid);
        }
        else if (kind == 3) {
            pg8::Gemm g{HB, (const bf16_t*)(args.ws + WS_WF1) + (size_t)layer * 2 * DFF * D, D, D, 0}; pg8::StaticOrder S; S.init(M, 2 * DFF, F.G, (int)blockIdx.x);
            pg8::EpiSwiglu E{(bf16_t*)(args.ws + WS_HID), SSQ};
            if (PH_ON(3)) pg8::gemm_phase<pg8::EpiSwiglu, true, true>(F.lds, g, S, E, F.tid);
        }
        else if (kind == 5) {
            if (PH_ON(4)) gates_part(F, jl);
            pg8::Gemm g{HB, (const bf16_t*)(args.ws + WS_WIN) + (size_t)jl * INW_MAIN * D, D, D, 0}; pg8::StaticOrder S; S.init(M, INW_MAIN, F.G, (int)blockIdx.x);
            pg8::EpiInProj E{(bf16_t*)(args.ws + WS_QKO), (bf16_t*)(args.ws + WS_KT), (bf16_t*)(args.ws + WS_VT), SSQ};
            if (PH_ON(5)) pg8::gemm_phase<pg8::EpiInProj, true, true>(F.lds, g, S, E, F.tid);
        }
        else if (kind == 6) { if (PH_ON(6)) scan_phase(F); }
        else if (kind == 7) { if (PH_ON(7)) out_phase(F); }
        else { if (PH_ON(8)) final_norm(F); }
        if (ph + 1 < hi) xcd_barrier(bar);
    }
}

extern "C" void kernel_launch(void* const* d_in, const int* in_sizes, int n_in, void* d_out, int out_size, void* d_ws, size_t ws_size, hipStream_t stream) {
    static int grid = 0;
    if (grid == 0) {
        if (n_in != 13 || in_sizes[0] != M * D || out_size != M * D || ws_size < WS_END) { fprintf(stderr, "kernel_launch: unexpected shapes (n_in %d, in0 %d, out %d, ws %zu)\n", n_in, n_in > 0 ? in_sizes[0] : -1, out_size, ws_size); grid = -1; return; }
        int dev = 0, cus = 0, per_cu = 0;
        if (hipGetDevice(&dev) != hipSuccess || hipDeviceGetAttribute(&cus, hipDeviceAttributeMultiprocessorCount, dev) != hipSuccess) { grid = -1; return; }
        if (hipFuncSetAttribute((const void*)mk_fwd, hipFuncAttributeMaxDynamicSharedMemorySize, LDS_BYTES) != hipSuccess) { fprintf(stderr, "kernel_launch: hipFuncSetAttribute failed\n"); grid = -1; return; }
        if (hipOccupancyMaxActiveBlocksPerMultiprocessor(&per_cu, (const void*)mk_fwd, NTHREADS, LDS_BYTES) != hipSuccess || per_cu < 1)
            fprintf(stderr, "kernel_launch: note: occupancy query reports %d workgroups per CU\n", per_cu);
        (void)hipGetLastError();
        grid = cus;
    }
    if (grid < 0) return;
    if (hipMemsetAsync((char*)d_ws + WS_CTL, 0, CTL_ZERO_BYTES, stream) != hipSuccess) return;
    Args a{};
    for (int i = 0; i < 13; ++i) a.in[i] = (const float*)d_in[i];
    a.out = (float*)d_out; a.ws = (unsigned char*)d_ws;
#if MK_N_LAUNCHES == 1
    a.ph_lo = 0; a.ph_hi = NPHASES;
    hipLaunchKernelGGL(mk_fwd, dim3(grid), dim3(NTHREADS), LDS_BYTES, stream, a);
#else
    for (int p = 0; p < NPHASES; ++p) { a.ph_lo = p; a.ph_hi = p + 1; hipLaunchKernelGGL(mk_fwd, dim3(grid), dim3(NTHREADS), LDS_BYTES, stream, a); }
#endif
}
```

```cpp
#include <hip/hip_runtime.h>
#include <cstdio>
#include <cstdint>

#ifndef MK_N_LAUNCHES
#define MK_N_LAUNCHES 1
#endif
#ifndef PH_MASK
#define PH_MASK 0x1ff
#endif
#define PH_ON(k) ((PH_MASK >> (k)) & 1)
#ifndef PROBE_KIND
#define PROBE_KIND -1
#endif
#ifndef PROBE_REP
#define PROBE_REP 0
#endif

#define LAS __attribute__((address_space(3)))
#define GAS __attribute__((address_space(1)))
typedef unsigned short bf16_t;
typedef short bf16x8 __attribute__((ext_vector_type(8)));
typedef float f32x4 __attribute__((ext_vector_type(4)));
typedef float f32x2 __attribute__((ext_vector_type(2)));
typedef unsigned u32x4 __attribute__((ext_vector_type(4)));
typedef unsigned u32x2 __attribute__((ext_vector_type(2)));
typedef GAS unsigned gu32;

constexpr int D = 1024, BATCH = 4, SEQ = 4096, M = BATCH * SEQ, DEPTH = 4;
constexpr int NH = 4, DV = 256, DQK = 128, INW = 3080, INW_MAIN = 3072;
constexpr int DFF = 2816;
constexpr int LC = 256, NCH = SEQ / LC, NSTREAM = BATCH * NH;
constexpr float EPS = 1e-6f;
constexpr int NWAVES = 8, NTHREADS = 512;
constexpr int NPHASES = 21;

constexpr size_t MiB = 1u << 20;
constexpr size_t WS_CTL = 0, CTL_ZERO_BYTES = 64 * 1024;
constexpr size_t WS_WPOOL = 1 * MiB;
constexpr size_t WS_WG = 2 * MiB;
constexpr size_t WS_WGB = WS_WG + 128 * 1024;
constexpr size_t WS_WIN = 3 * MiB;
constexpr size_t WS_WOUT = 15 * MiB;
constexpr size_t WS_WF1 = 19 * MiB;
constexpr size_t WS_WF2 = 63 * MiB;
constexpr size_t WS_HB = 85 * MiB;
constexpr size_t WS_SSQ = 117 * MiB;
constexpr size_t WS_GI = 118 * MiB;
constexpr size_t WS_GF = WS_GI + 256 * 1024;
constexpr size_t WS_TA = WS_GF + 256 * 1024;
constexpr size_t WS_TM = WS_TA + 256 * 1024;
constexpr size_t WS_TB = WS_TM + 256 * 1024;
constexpr size_t WS_MPREV = WS_TB + 256 * 1024;
constexpr size_t WS_DEC = WS_MPREV + 2048;
constexpr size_t WS_NST = WS_MPREV + 4096;
constexpr size_t WS_LOCN = WS_NST + 131072;
constexpr size_t WS_R = 120 * MiB;
constexpr size_t WS_HID = WS_R;
constexpr size_t WS_KT = WS_R + 88 * MiB;
constexpr size_t WS_VT = WS_R + 104 * MiB;
constexpr size_t WS_HG = WS_R + 136 * MiB;
constexpr size_t WS_LOC = WS_R + 217 * MiB;
constexpr size_t WS_CST = WS_R + 168 * MiB;
constexpr size_t WS_HB2 = WS_R + 184 * MiB;
constexpr size_t WS_SSQ2 = WS_R + 216 * MiB;
constexpr size_t WS_END = WS_R + 232 * MiB;
static_assert(WS_HID + (size_t)M * DFF * 2 <= WS_KT && WS_LOCN + 16 * 15 * 128 * 4 <= WS_R && WS_LOC + (size_t)16 * 15 * 256 * 128 * 2 <= WS_END && WS_HG + (size_t)M * D * 2 <= WS_CST && WS_WF2 + (size_t)4 * 1024 * 2816 * 2 <= WS_HB, "d_ws map");
constexpr int CW_BAR = 1024;
constexpr int CW_TEAM = 12288;
constexpr int CW_STREAM = 13312;
constexpr int CW_PANEL = 8192;
static_assert((CW_PANEL + 64 * 64) * 4 <= (int)CTL_ZERO_BYTES, "panel counters inside the memset region");

constexpr int RING_BYTES = 131072;
constexpr int XPOSE_OFF = RING_BYTES, XPOSE_BYTES = 8 * 2304;
constexpr int RINVL_OFF = XPOSE_OFF + XPOSE_BYTES, RINVL_BYTES = 8 * 1024;
constexpr int PA_LG = 272, PA_BLK = 4 * PA_LG, PA_BYTES = 128 * PA_BLK, PA_RINV_OFF = PA_BYTES;
constexpr int BASE8_OFF = XPOSE_OFF + 8 * 1024;
constexpr int LDSCTL_OFF = 160 * 1024 - 1024, MISC_OFF = LDSCTL_OFF + 320;
static_assert(BASE8_OFF + 16384 <= LDSCTL_OFF, "LDS map (base piece)");
static_assert(PA_RINV_OFF + 272 * 4 <= XPOSE_OFF + 5 * 1024 + 8 * 1024 && PA_RINV_OFF + 272 * 4 <= LDSCTL_OFF, "pool phase LDS map");
static_assert(8 * 16640 <= LDSCTL_OFF && RINVL_OFF + RINVL_BYTES <= LDSCTL_OFF, "LDS map");
constexpr int LDS_BYTES = 163840;

#define RLX_AGENT __ATOMIC_RELAXED, __HIP_MEMORY_SCOPE_AGENT
#define LDS_WAIT() asm volatile("s_waitcnt lgkmcnt(0)" ::: "memory")
#define VM_WAIT() asm volatile("s_waitcnt vmcnt(0)" ::: "memory")

typedef __bf16 bf16v2 __attribute__((ext_vector_type(2)));
__device__ __forceinline__ unsigned cvt_pk_bf16(float lo, float hi) { const bf16v2 r = __builtin_convertvector((f32x2){lo, hi}, bf16v2); return __builtin_bit_cast(unsigned, r); }
__device__ __forceinline__ void st16_wt(void* base, unsigned byte_off, u32x4 v) {
    __builtin_amdgcn_raw_buffer_store_b128(v, __builtin_amdgcn_make_buffer_rsrc(base, 0, 0x7fffffff, 0x00020000), byte_off, 0, 16);
}
__device__ __forceinline__ float bf2f(unsigned short b) { return __uint_as_float(((unsigned)b) << 16); }
__device__ __forceinline__ float bflo(unsigned u) { return __uint_as_float(u << 16); }
__device__ __forceinline__ float bfhi(unsigned u) { return __uint_as_float(u & 0xffff0000u); }
__device__ __forceinline__ float lane_get(float v, int src) { return __builtin_bit_cast(float, __builtin_amdgcn_ds_bpermute(src << 2, __builtin_bit_cast(int, v))); }
__device__ __forceinline__ float lane_xor(float v, int mask, int lane) { return lane_get(v, lane ^ mask); }
__device__ __forceinline__ float wave_sum(float v, int lane) {
#pragma unroll
    for (int o = 1; o < 64; o <<= 1) v += lane_xor(v, o, lane);
    return v;
}
__device__ __forceinline__ float rinv_of(const f32x4 s) { return __builtin_amdgcn_rsqf(((s.x + s.y) + (s.z + s.w)) * (1.0f / D) + EPS); }

namespace pg8 {
constexpr int BM = 256, BK = 64, HALF = 128, HTB = HALF * BK * 2, STAGE_BYTES = 8 * HTB, NXCD = 8, WGM = 8;
__host__ __device__ __forceinline__ int lds_byte(int r, int c) { const int st = (r >> 4) * 2 + (c >> 5), rr = r & 15, cc = c & 31, ob = rr * 64 + cc * 2; return st * 1024 + (ob ^ (((ob >> 9) & 1) << 5)); }
__host__ __device__ __forceinline__ void stage_rc(int b, int& R, int& C) { const int st = b / 1024, sb = b % 1024, swz = sb ^ (((sb >> 9) & 1) << 5); R = (st >> 1) * 16 + swz / 64; C = (st & 1) * 32 + (swz % 64) / 2; }
__host__ __device__ __forceinline__ int perm32(int rho) { const int n = rho >> 4, i = rho & 15; return 8 * (i >> 2) + 4 * n + (i & 3); }

struct Unit { int pm, pn; };
struct Gemm { const bf16_t* A; const bf16_t* Bt; int lda, K, grouped; };

struct StaticOrder {
    int nM, nN, nwg, G, c;
    __device__ __forceinline__ void init(int M_, int N_, int G_, int c_) { nM = M_ / BM; nN = N_ / BM; nwg = nM * nN; G = G_; c = c_; }
    __device__ __forceinline__ bool next(int i, Unit& u) const {
        const long L = (long)i * G + c; if (L >= nwg) return false;
        int wgid = (int)L; { const int q = nwg / NXCD, r = nwg % NXCD, xcd = wgid % NXCD, off = wgid / NXCD; wgid = (xcd < r ? xcd * (q + 1) : r * (q + 1) + (xcd - r) * q) + off; }
        const int nig = WGM * nN, gid = wgid / nig, fm = gid * WGM, gsz = (nM - fm) < WGM ? (nM - fm) : WGM;
        u.pm = fm + ((wgid % nig) % gsz); u.pn = (wgid % nig) / gsz; return true;
    }
};


struct EpiSwiglu {
    static constexpr bool PERM = true, AFTER_DRAIN = false, SWAPS = false;
    bf16_t* O; const LAS float* rl;
    __device__ __forceinline__ void operator()(const f32x4 (&acc)[2][2][4][2], const Unit& u, int ui, int wr, int wc, int fr, int fq) const {
        const int row0 = u.pm * BM + wr * 64 + fr, col0 = u.pn * 128 + wc * 32 + 8 * fq;
#pragma unroll
        for (int ai = 0; ai < 2; ++ai)
#pragma unroll
            for (int m = 0; m < 4; ++m) {
                const int row = row0 + ai * HALF + m * 16;
                const float ri = rl[ui * 256 + wr * 64 + fr + ai * HALF + m * 16];
                float h[8];
#pragma unroll
                for (int n = 0; n < 2; ++n)
#pragma unroll
                    for (int j = 0; j < 4; ++j) {
                        const float g = acc[ai][0][m][n][j] * ri, up = acc[ai][1][m][n][j] * ri;
                        h[n * 4 + j] = g * __builtin_amdgcn_rcpf(1.0f + __expf(-g)) * up;
                    }
                u32x4 w; w.x = cvt_pk_bf16(h[0], h[1]); w.y = cvt_pk_bf16(h[2], h[3]); w.z = cvt_pk_bf16(h[4], h[5]); w.w = cvt_pk_bf16(h[6], h[7]);
                st16_wt(O, (unsigned)((row * DFF + col0) * 2), w);
            }
    }
};
struct EpiInProj {
    static constexpr bool PERM = true, AFTER_DRAIN = false, SWAPS = true;
    bf16_t* QKO; bf16_t* KT; bf16_t* VT; const LAS float* rl; LAS unsigned char* xb;
    __device__ __forceinline__ bool swapped(const Unit& u) const { return u.pn >= 4 && u.pn < 8; }
    __device__ __forceinline__ void operator()(f32x4 (&acc)[2][2][4][2], const Unit& u, int ui, int wr, int wc, int fr_, int fq_) const {
        int fr = fr_, fq = fq_; asm volatile("" : "+v"(fr), "+v"(fq));
        const int row0 = u.pm * BM + wr * 64 + fr;
        const int pn = u.pn;
        const bool is_v = (pn >= 4 && pn < 8);
        const int bb = (u.pm * BM) / SEQ;
        if (is_v) {
            asm volatile("" ::: "memory");
            const __amdgpu_buffer_rsrc_t rV = __builtin_amdgcn_make_buffer_rsrc(VT, 0, 0x7fffffff, 0x00020000);
            const unsigned vo = (unsigned)((fr * SEQ + wc * 32 + 8 * fq) * 2);
            const unsigned so = (unsigned)((((bb * NH + (pn - 4)) * DV + wr * 64) * SEQ + (u.pm * BM) % SEQ) * 2);
#pragma unroll
            for (int bj = 0; bj < 2; ++bj) {
                const f32x4 rv0 = *(const LAS f32x4*)(rl + ui * 256 + bj * HALF + wc * 32 + 8 * fq), rv1 = *(const LAS f32x4*)(rl + ui * 256 + bj * HALF + wc * 32 + 8 * fq + 4);
#pragma unroll
                for (int ai = 0; ai < 2; ++ai)
#pragma unroll
                    for (int m = 0; m < 4; ++m) {
                        const f32x4 v0 = acc[ai][bj][m][0] * rv0, v1 = acc[ai][bj][m][1] * rv1;
                        u32x4 w; w.x = cvt_pk_bf16(v0[0], v0[1]); w.y = cvt_pk_bf16(v0[2], v0[3]); w.z = cvt_pk_bf16(v1[0], v1[1]); w.w = cvt_pk_bf16(v1[2], v1[3]);
                        __builtin_amdgcn_raw_buffer_store_b128(w, rV, vo, so + (unsigned)(((ai * HALF + m * 16) * SEQ + bj * HALF) * 2), 0); }
                __builtin_amdgcn_sched_barrier(0);
            }
            return;
        }
        asm volatile("" ::: "memory");
        const int ncol0 = (pn < 4 ? pn * 256 : (pn - 4) * 256) + wc * 32 + 8 * fq;
#pragma unroll
        for (int ai = 0; ai < 2; ++ai)
#pragma unroll
            for (int m = 0; m < 4; ++m) { const int row = row0 + ai * HALF + m * 16; const float ri = rl[ui * 256 + wr * 64 + fr + ai * HALF + m * 16];
#pragma unroll
                for (int bj = 0; bj < 2; ++bj) { const f32x4 v0 = acc[ai][bj][m][0] * ri, v1 = acc[ai][bj][m][1] * ri;
                    u32x4 w; w.x = cvt_pk_bf16(v0[0], v0[1]); w.y = cvt_pk_bf16(v0[2], v0[3]); w.z = cvt_pk_bf16(v1[0], v1[1]); w.w = cvt_pk_bf16(v1[2], v1[3]);
                    *(u32x4*)(QKO + (size_t)row * 2048 + ncol0 + bj * HALF) = w; } }
    }
};
struct EpiResid {
    static constexpr bool PERM = true, AFTER_DRAIN = true, SWAPS = false;
    const float* basef; const bf16_t* hbr; bf16_t* hb; float* ssq;
    bool lds_base;
    const float* fgain; float* fout; unsigned* pcnt;
    __device__ __forceinline__ void fused(f32x4 (&acc)[2][2][4][2], const Unit& u, int wr, int wc, int fr, int fq, LAS unsigned char* lds, int wid, int lane) const {
        LAS float* P = (LAS float*)(lds + XPOSE_OFF);
        LAS float* R = P + 1024;
        const int col0 = u.pn * BM + wc * 32 + 8 * fq;
        const bool fin = (fgain != nullptr);
#pragma unroll
        for (int ai = 0; ai < 2; ++ai) {
            const size_t off0 = (size_t)(u.pm * BM + ai * HALF + wr * 64 + fr) * D + col0;
            if (basef) {
#pragma unroll
                for (int m = 0; m < 4; ++m)
#pragma unroll
                    for (int bj = 0; bj < 2; ++bj) { const float* bp = basef + off0 + (size_t)m * 16 * D + bj * HALF;
                        acc[ai][bj][m][0] += *(const f32x4*)bp; acc[ai][bj][m][1] += *(const f32x4*)(bp + 4); }
            } else {
                u32x4 hv[4][2];
#pragma unroll
                for (int m = 0; m < 4; ++m)
#pragma unroll
                    for (int bj = 0; bj < 2; ++bj) {
                        const int ch = 2 * bj + (wc >> 1);
                        if (lds_base) {
                            const int so = (ch == 3 && ai == 1) ? BASE8_OFF : ((ch == 0) ? ai : (ch == 1) ? 4 + ai : (ch == 2) ? 6 + ai : 2) * HTB;
                            hv[m][bj] = *(const LAS u32x4*)(lds + so + lds_byte(wr * 64 + m * 16 + fr, (wc & 1) * 32 + 8 * fq));
                        } else hv[m][bj] = *(const u32x4*)(hbr + off0 + (size_t)m * 16 * D + bj * HALF); }
#pragma unroll
                for (int m = 0; m < 4; ++m)
#pragma unroll
                    for (int bj = 0; bj < 2; ++bj) { const u32x4 h = hv[m][bj];
                        acc[ai][bj][m][0] += (f32x4){bflo(h.x), bfhi(h.x), bflo(h.y), bfhi(h.y)}; acc[ai][bj][m][1] += (f32x4){bflo(h.z), bfhi(h.z), bflo(h.w), bfhi(h.w)}; }
            }
#pragma unroll
            for (int m = 0; m < 4; ++m) { const int r = ai * HALF + wr * 64 + m * 16 + fr; float ss = 0.f;
#pragma unroll
                for (int bj = 0; bj < 2; ++bj) { const f32x4 o0 = acc[ai][bj][m][0], o1 = acc[ai][bj][m][1];
                    if (!fin) { u32x4 w; w.x = cvt_pk_bf16(o0[0], o0[1]); w.y = cvt_pk_bf16(o0[2], o0[3]); w.z = cvt_pk_bf16(o1[0], o1[1]); w.w = cvt_pk_bf16(o1[2], o1[3]);
                        st16_wt(hb, (unsigned)((off0 + (size_t)m * 16 * D + bj * HALF) * 2), w); }
                    ss += ((o0[0] * o0[0] + o0[1] * o0[1]) + (o0[2] * o0[2] + o0[3] * o0[3])) + ((o1[0] * o1[0] + o1[1] * o1[1]) + (o1[2] * o1[2] + o1[3] * o1[3])); }
                ss += lane_xor(ss, 16, lane); ss += lane_xor(ss, 32, lane);
                if (fq == 0) P[r * 4 + wc] = ss; }
            asm volatile("" ::: "memory");
        }
        asm volatile("s_waitcnt lgkmcnt(0)" ::: "memory"); __builtin_amdgcn_s_barrier(); asm volatile("" ::: "memory");
        const int tid = wid * 64 + lane;
        if (!fin) {
            if (tid < 256) { const f32x4 p = *(LAS f32x4*)(P + tid * 4); __hip_atomic_store((unsigned*)(ssq + (size_t)(u.pm * BM + tid) * 4 + u.pn), __float_as_uint((p.x + p.y) + (p.z + p.w)), __ATOMIC_RELAXED, __HIP_MEMORY_SCOPE_AGENT); }
            return;
        }
        float* slot = ssq + (size_t)(u.pm * BM) * 4;
        if (tid < 256) { const f32x4 p = *(LAS f32x4*)(P + tid * 4); __hip_atomic_store((unsigned*)(slot + tid * 4 + u.pn), __float_as_uint((p.x + p.y) + (p.z + p.w)), __ATOMIC_RELAXED, __HIP_MEMORY_SCOPE_AGENT); }
        asm volatile("s_waitcnt vmcnt(0)" ::: "memory");
        __builtin_amdgcn_s_barrier(); asm volatile("" ::: "memory");
        if (tid == 0) {
            unsigned* c = pcnt + 64 * u.pm;
            __hip_atomic_fetch_add(c, 1u, __ATOMIC_RELAXED, __HIP_MEMORY_SCOPE_AGENT);
            unsigned spins = 0;
            while (__hip_atomic_load(c, __ATOMIC_RELAXED, __HIP_MEMORY_SCOPE_AGENT) < 4u) { __builtin_amdgcn_s_sleep(2); if (++spins > (1u << 20)) break; }
            __builtin_amdgcn_fence(__ATOMIC_ACQUIRE, "agent");
            asm volatile("s_waitcnt vmcnt(0)" ::: "memory");
        }
        __builtin_amdgcn_s_barrier(); asm volatile("" ::: "memory");
        if (tid < 256) {
            const u32x4 pv = __builtin_amdgcn_raw_buffer_load_b128(__builtin_amdgcn_make_buffer_rsrc((void*)slot, 0, 0x7fffffff, 0x00020000), (unsigned)(tid * 16), 0u, 16);
            const float t4 = (__uint_as_float(pv.x) + __uint_as_float(pv.y)) + (__uint_as_float(pv.z) + __uint_as_float(pv.w));
            R[tid] = __builtin_amdgcn_rsqf(t4 * (1.0f / D) + EPS); }
        asm volatile("s_waitcnt lgkmcnt(0)" ::: "memory"); __builtin_amdgcn_s_barrier(); asm volatile("" ::: "memory");
#pragma unroll
        for (int bj = 0; bj < 2; ++bj) {
            const f32x4 g0 = *(const f32x4*)(fgain + col0 + bj * HALF), g1 = *(const f32x4*)(fgain + col0 + bj * HALF + 4);
#pragma unroll
            for (int ai = 0; ai < 2; ++ai)
#pragma unroll
                for (int m = 0; m < 4; ++m) { const int r = ai * HALF + wr * 64 + m * 16 + fr; const float ri = R[r];
                    float* op = fout + (size_t)(u.pm * BM + r) * D + col0 + bj * HALF;
                    *(f32x4*)op = acc[ai][bj][m][0] * ri * g0; *(f32x4*)(op + 4) = acc[ai][bj][m][1] * ri * g1; }
        }
    }
};

template <class Epi, bool ALIGN_EPI, bool SP2>
__device__ __forceinline__ void gemm_phase(LAS unsigned char* lds, const Gemm g, const StaticOrder& S, const Epi& E, const int tid, const bf16_t* tail = nullptr) {
    const int wid = __builtin_amdgcn_readfirstlane(tid >> 6), lane = tid & 63, wr = wid >> 2, wc = wid & 3, fr = lane & 15, fq = lane >> 4;
    const int K = g.K, nt = K / BK, lda = g.lda;
    unsigned voffA[2], voffB[2];
#pragma unroll
    for (int i = 0; i < 2; ++i) { int R, C; stage_rc(tid * 16 + i * 8192, R, C); const int Rb = Epi::PERM ? ((R & ~31) + perm32(R & 31)) : R;
        voffA[i] = (unsigned)(R * lda + C) * 2u; voffB[i] = (unsigned)(Rb * K + C) * 2u; }
    const size_t kstep = (size_t)(BK * 2);
    const size_t hstepA = (size_t)HALF * lda * 2, hstepB = (size_t)HALF * K * 2;
    const size_t tstepA = 2 * hstepA, tstepB = 2 * hstepB;
    const size_t gstep = g.grouped ? (size_t)K * 2 : 0;
    const unsigned ldsw = (unsigned)wid * 1024u;
    const int aoff = lds_byte(wr * 64 + fr, fq * 8), boff = lds_byte(wc * 32 + fr, fq * 8);
#define PG8_SA(b, h) (((b) * 2 + (h)) * HTB)
#define PG8_SB(b, h) ((4 + (b) * 2 + (h)) * HTB)
#define PG8_STAGE(bufoff, gbase, voff) do { _Pragma("unroll") for (int _i = 0; _i < 2; ++_i) \
        __builtin_amdgcn_global_load_lds((const unsigned*)((const char*)(gbase) + (voff)[_i]), (LAS unsigned*)(lds + (bufoff) + ldsw + _i * 8192), 16, 0, 0); } while (0)
#define PG8_LDA(dst, b, h) do { _Pragma("unroll") for (int m = 0; m < 4; ++m) _Pragma("unroll") for (int k = 0; k < 2; ++k) dst[m][k] = *(const LAS bf16x8*)(lds + PG8_SA(b, h) + aoff + m * 2048 + k * 1024); } while (0)
#define PG8_LDB(dst, b, h) do { _Pragma("unroll") for (int n = 0; n < 2; ++n) _Pragma("unroll") for (int k = 0; k < 2; ++k) dst[n][k] = *(const LAS bf16x8*)(lds + PG8_SB(b, h) + boff + n * 2048 + k * 1024); } while (0)
#define PG8_MMA(ai, bj, At, Bt) do { __builtin_amdgcn_s_setprio(1); _Pragma("unroll") for (int m = 0; m < 4; ++m) _Pragma("unroll") for (int n = 0; n < 2; ++n) _Pragma("unroll") for (int k = 0; k < 2; ++k) \
        acc[ai][bj][m][n] = __builtin_amdgcn_mfma_f32_16x16x32_bf16(Bt[n][k], At[m][k], acc[ai][bj][m][n], 0, 0, 0); __builtin_amdgcn_s_setprio(0); } while (0)
#define PG8_WAIT_V(n) asm volatile("s_waitcnt vmcnt(" #n ")" ::: "memory")
#define PG8_WAIT_L(n) asm volatile("s_waitcnt lgkmcnt(" #n ")" ::: "memory")
#define PG8_BAR __builtin_amdgcn_s_barrier()
#define PG8_SCHED __builtin_amdgcn_sched_barrier(0)
    Unit cur, nxt; int ui = 0;
    if (!S.next(0, cur)) return;
    f32x4 acc[2][2][4][2];
#pragma unroll
    for (int a = 0; a < 2; ++a)
#pragma unroll
        for (int b = 0; b < 2; ++b)
#pragma unroll
            for (int m = 0; m < 4; ++m)
#pragma unroll
                for (int n = 0; n < 2; ++n) acc[a][b][m][n] = (f32x4){0.f, 0.f, 0.f, 0.f};
    bf16x8 At[4][2], B0[2][2], B1[2][2];
    const char* cA = (const char*)g.A + (size_t)cur.pm * tstepA + (size_t)cur.pn * gstep; const char* cB = (const char*)g.Bt + (size_t)cur.pn * tstepB;
    if constexpr (Epi::SWAPS) { if (E.swapped(cur)) { const char* t_ = cA; cA = cB; cB = t_; } }
    if constexpr (SP2) {
        if constexpr (Epi::AFTER_DRAIN) { if (tail != nullptr) {
            unsigned vh[2];
#pragma unroll
            for (int i = 0; i < 2; ++i) { int R, C; stage_rc(tid * 16 + i * 8192, R, C); vh[i] = (unsigned)(R * D + C) * 2u; }
            const char* p31 = (const char*)tail + ((size_t)cur.pm * BM * D + (size_t)cur.pn * BM + (size_t)HALF * D + 3 * 64) * 2;
            PG8_STAGE(BASE8_OFF, p31, vh); } }
        PG8_STAGE(PG8_SB(0, 0), cB, voffB); PG8_STAGE(PG8_SB(0, 1), cB + hstepB, voffB); PG8_STAGE(PG8_SA(0, 0), cA, voffA); PG8_STAGE(PG8_SA(0, 1), cA + hstepA, voffA);
        if (wr == 1) PG8_BAR;
        PG8_WAIT_V(2); PG8_BAR;
        PG8_STAGE(PG8_SB(1, 0), cB + kstep, voffB); PG8_STAGE(PG8_SA(1, 0), cA + kstep, voffA); PG8_STAGE(PG8_SB(1, 1), cB + hstepB + kstep, voffB);
        PG8_WAIT_V(6); PG8_BAR;
    } else {
        PG8_STAGE(PG8_SB(0, 0), cB, voffB); PG8_STAGE(PG8_SA(0, 0), cA, voffA); PG8_STAGE(PG8_SB(0, 1), cB + hstepB, voffB); PG8_STAGE(PG8_SA(0, 1), cA + hstepA, voffA);
        if (wr == 1) PG8_BAR;
        PG8_WAIT_V(4); PG8_BAR;
        PG8_STAGE(PG8_SB(1, 0), cB + kstep, voffB); PG8_STAGE(PG8_SA(1, 0), cA + kstep, voffA); PG8_STAGE(PG8_SB(1, 1), cB + hstepB + kstep, voffB);
        PG8_WAIT_V(6); PG8_BAR;
    }
    for (;;) {
        const bool has_next = S.next(ui + 1, nxt);
        const char* nA = has_next ? (const char*)g.A + (size_t)nxt.pm * tstepA + (size_t)nxt.pn * gstep : cA; const char* nB = has_next ? (const char*)g.Bt + (size_t)nxt.pn * tstepB : cB;
        if constexpr (Epi::SWAPS) { if (has_next && E.swapped(nxt)) { const char* t_ = nA; nA = nB; nB = t_; } }
        for (int t = 0; t < nt; t += 2) {
            const bool last = (t == nt - 2);
            const char* a1 = cA + (size_t)(t + 1) * kstep;
            const char* a2 = last ? nA : cA + (size_t)(t + 2) * kstep; const char* b2 = last ? nB : cB + (size_t)(t + 2) * kstep;
            const char* a3 = a2 + kstep; const char* b3 = b2 + kstep;
            if constexpr (SP2) {
            const bool tl = Epi::AFTER_DRAIN && last && !has_next && tail != nullptr;
            const char* tp = (const char*)tail + ((size_t)cur.pm * BM * D + (size_t)cur.pn * BM) * 2;
#define PG8_PIECE(ch, rh) (tp + ((size_t)(rh) * HALF * D + (ch) * 64) * 2)
#define PG8_VOFFH unsigned voffH[2]; { unsigned o_ = ~0u; asm volatile("" : "+s"(o_)); const int tid_ = wid * 64 + (int)__builtin_amdgcn_mbcnt_hi(o_, __builtin_amdgcn_mbcnt_lo(o_, 0u));   \
        _Pragma("unroll") for (int i_ = 0; i_ < 2; ++i_) { int R_, C_; stage_rc(tid_ * 16 + i_ * 8192, R_, C_); voffH[i_] = (unsigned)(R_ * D + C_) * 2u; } }
            PG8_LDB(B0, 0, 0); PG8_LDB(B1, 0, 1); PG8_SCHED; PG8_LDA(At, 0, 0); PG8_STAGE(PG8_SA(1, 1), a1 + hstepA, voffA);
            PG8_WAIT_V(8); PG8_WAIT_L(0); PG8_BAR; PG8_MMA(0, 0, At, B0); PG8_MMA(0, 1, At, B1); PG8_BAR; PG8_SCHED;
            PG8_LDA(At, 0, 1);
            if (tl) { PG8_VOFFH; PG8_STAGE(PG8_SB(0, 0), PG8_PIECE(1, 0), voffH); PG8_STAGE(PG8_SB(0, 1), PG8_PIECE(1, 1), voffH); PG8_STAGE(PG8_SA(0, 0), PG8_PIECE(0, 0), voffH); }
            else    { PG8_STAGE(PG8_SB(0, 0), b2, voffB); PG8_STAGE(PG8_SB(0, 1), b2 + hstepB, voffB); PG8_STAGE(PG8_SA(0, 0), a2, voffA); }
            PG8_WAIT_V(8); PG8_WAIT_L(0); PG8_BAR; PG8_MMA(1, 0, At, B0); PG8_MMA(1, 1, At, B1); PG8_BAR; PG8_SCHED;
            PG8_LDB(B0, 1, 0); PG8_LDB(B1, 1, 1); PG8_SCHED; PG8_LDA(At, 1, 0);
            if (tl) { PG8_VOFFH; PG8_STAGE(PG8_SA(0, 1), PG8_PIECE(0, 1), voffH); } else { PG8_STAGE(PG8_SA(0, 1), a2 + hstepA, voffA); }
            PG8_WAIT_V(8); PG8_WAIT_L(0); PG8_BAR; PG8_MMA(0, 0, At, B0); PG8_MMA(0, 1, At, B1); PG8_BAR; PG8_SCHED;
            PG8_LDA(At, 1, 1);
            if (tl) { PG8_VOFFH; PG8_STAGE(PG8_SB(1, 0), PG8_PIECE(2, 0), voffH); PG8_STAGE(PG8_SB(1, 1), PG8_PIECE(2, 1), voffH); PG8_STAGE(PG8_SA(1, 0), PG8_PIECE(3, 0), voffH); }
            else    { PG8_STAGE(PG8_SB(1, 0), b3, voffB); PG8_STAGE(PG8_SB(1, 1), b3 + hstepB, voffB); PG8_STAGE(PG8_SA(1, 0), a3, voffA); }
            PG8_WAIT_V(8); PG8_WAIT_L(0); PG8_BAR; PG8_MMA(1, 0, At, B0); PG8_MMA(1, 1, At, B1); PG8_BAR; PG8_SCHED;
#undef PG8_PIECE
#undef PG8_VOFFH
            } else {
            PG8_LDB(B0, 0, 0); PG8_SCHED; PG8_LDA(At, 0, 0); PG8_STAGE(PG8_SA(1, 1), a1 + hstepA, voffA);
            PG8_WAIT_L(8); PG8_BAR; PG8_WAIT_L(0); PG8_MMA(0, 0, At, B0); PG8_BAR; PG8_SCHED;
            PG8_LDB(B1, 0, 1); PG8_STAGE(PG8_SB(0, 0), b2, voffB);
            PG8_BAR; PG8_WAIT_L(0); PG8_MMA(0, 1, At, B1); PG8_BAR;
            PG8_LDA(At, 0, 1); PG8_STAGE(PG8_SA(0, 0), a2, voffA);
            PG8_BAR; PG8_WAIT_L(0); PG8_MMA(1, 0, At, B0); PG8_BAR; PG8_SCHED;
            PG8_STAGE(PG8_SB(0, 1), b2 + hstepB, voffB);
            PG8_WAIT_V(6); PG8_BAR; PG8_MMA(1, 1, At, B1); PG8_BAR;
            PG8_LDB(B0, 1, 0); PG8_SCHED; PG8_LDA(At, 1, 0); PG8_STAGE(PG8_SA(0, 1), a2 + hstepA, voffA);
            PG8_WAIT_L(8); PG8_BAR; PG8_WAIT_L(0); PG8_MMA(0, 0, At, B0); PG8_BAR; PG8_SCHED;
            PG8_LDB(B1, 1, 1); PG8_STAGE(PG8_SB(1, 0), b3, voffB);
            PG8_BAR; PG8_WAIT_L(0); PG8_MMA(0, 1, At, B1); PG8_BAR;
            PG8_LDA(At, 1, 1); PG8_STAGE(PG8_SA(1, 0), a3, voffA);
            PG8_BAR; PG8_WAIT_L(0); PG8_MMA(1, 0, At, B0); PG8_BAR; PG8_SCHED;
            PG8_STAGE(PG8_SB(1, 1), b3 + hstepB, voffB);
            PG8_WAIT_V(6); PG8_BAR; PG8_MMA(1, 1, At, B1); PG8_BAR;
            }
        }
        if constexpr (ALIGN_EPI) { if (wr == 0) PG8_BAR; }
        if constexpr (!Epi::AFTER_DRAIN) { E(acc, cur, ui, wr, wc, fr, fq); }
        if (!has_next) break;
#pragma unroll
        for (int a = 0; a < 2; ++a)
#pragma unroll
            for (int b = 0; b < 2; ++b)
#pragma unroll
                for (int m = 0; m < 4; ++m)
#pragma unroll
                    for (int n = 0; n < 2; ++n) acc[a][b][m][n] = (f32x4){0.f, 0.f, 0.f, 0.f};
        cur = nxt; cA = nA; cB = nB; ++ui;
        if constexpr (ALIGN_EPI) { if (wr == 1) PG8_BAR; }
    }
    PG8_WAIT_V(0);
    if constexpr (!ALIGN_EPI) { if (wr == 0) PG8_BAR; }
    PG8_BAR;
    if constexpr (Epi::AFTER_DRAIN) { E.fused(acc, cur, wr, wc, fr, fq, lds, wid, lane); }
#undef PG8_SA
#undef PG8_SB
#undef PG8_STAGE
#undef PG8_LDA
#undef PG8_LDB
#undef PG8_MMA
#undef PG8_WAIT_V
#undef PG8_WAIT_L
#undef PG8_BAR
#undef PG8_SCHED
}
}

#define XB_TMO      128
#define XB_XCNT(j)  (256  + 64 * (j))
#define XB_XSUB(j)  (1280 + 64 * (j))
#define XB_XGEN(j)  (2304 + 64 * (j))
#define XB_TOP      3328
#define XB_TOPGEN   3392
#define XCD_BAR_WORDS 3456
#define XB_SPIN_CAP (1u << 18)
static_assert((CW_BAR + XCD_BAR_WORDS) * 4 <= (int)CTL_ZERO_BYTES, "barrier words inside the memset region");

__device__ __forceinline__ unsigned xb_ld(unsigned* p)              { return __hip_atomic_load(p, __ATOMIC_RELAXED, __HIP_MEMORY_SCOPE_AGENT); }
__device__ __forceinline__ unsigned xb_add(unsigned* p, unsigned v) { return __hip_atomic_fetch_add(p, v, __ATOMIC_RELAXED, __HIP_MEMORY_SCOPE_AGENT); }
__device__ __forceinline__ unsigned xb_xcc_id() { return (unsigned)__builtin_amdgcn_s_getreg((3 << 11) | 20) & 0xFu; }
#define XB_SPIN(cond, bar) do { unsigned _sp = 0; while (cond) { __builtin_amdgcn_s_sleep(1); \
    if ((++_sp & 255u) == 0u) { if (xb_ld(&(bar)[XB_TMO])) break; if (_sp > XB_SPIN_CAP) { atomicAdd(&(bar)[XB_TMO], 1u); break; } } } } while (0)

struct XcdBarrier { unsigned* bar; unsigned x; volatile LAS unsigned* st; };
__device__ __forceinline__ XcdBarrier xcd_barrier_post(unsigned* bar, volatile LAS unsigned* st) {
    XcdBarrier b; b.bar = bar; b.x = xb_xcc_id(); b.st = st;
    if (threadIdx.x == 0) (void)xb_add(&bar[XB_XCNT(b.x)], 1u);
    return b;
}
__device__ __forceinline__ void xcd_barrier_complete(unsigned* bar, unsigned x, unsigned& nloc, unsigned& nx) {
    const unsigned G = gridDim.x * gridDim.y * gridDim.z;
    unsigned sum, cnt, mine, sp = 0u;
    for (;;) {
        sum = 0u; cnt = 0u; mine = 0u;
        unsigned cv[16];
        { const __amdgpu_buffer_rsrc_t rb = __builtin_amdgcn_make_buffer_rsrc((void*)bar, 0, 0x7fffffff, 0x00020000);
#pragma unroll
          for (unsigned j = 0; j < 16; ++j) cv[j] = __builtin_amdgcn_raw_buffer_load_b32(rb, 0u, (unsigned)(XB_XCNT(j) * 4), 16); }
#pragma unroll
        for (unsigned j = 0; j < 16; ++j) { const unsigned c = cv[j]; sum += c; cnt += (c > 0u) ? 1u : 0u; mine = (j == x) ? c : mine; }
        if (sum == G) break;
        __builtin_amdgcn_s_sleep(1);
        if ((++sp & 255u) == 0u) { if (xb_ld(&bar[XB_TMO])) break; if (sp > XB_SPIN_CAP) { atomicAdd(&bar[XB_TMO], 1u); break; } }
    }
    nloc = mine > 0u ? mine : 1u; nx = cnt > 0u ? cnt : 1u;
}
__device__ __forceinline__ void xcd_barrier(const XcdBarrier& b, const bool leader) {
    asm volatile("s_waitcnt vmcnt(0)" ::: "memory");
    __syncthreads();
    if (leader) {
        unsigned* bar = b.bar;
        __builtin_amdgcn_s_waitcnt(0);
        unsigned nloc = b.st[0], nx = b.st[1];
        if (nloc == 0u) { xcd_barrier_complete(bar, b.x, nloc, nx); b.st[0] = nloc; b.st[1] = nx; }
        const unsigned old = xb_add(&bar[XB_XSUB(b.x)], 1u);
        const unsigned gen = old / nloc;
        if (old + 1u == (gen + 1u) * nloc) {
            __builtin_amdgcn_fence(__ATOMIC_RELEASE, "agent");
            asm volatile("s_waitcnt vmcnt(0)" ::: "memory");
            const unsigned og = xb_add(&bar[XB_TOP], 1u);
            const unsigned tg = og / nx;
            if (og + 1u == (tg + 1u) * nx) xb_add(&bar[XB_TOPGEN], 1u);
            else XB_SPIN(xb_ld(&bar[XB_TOPGEN]) == tg, bar);
            __builtin_amdgcn_fence(__ATOMIC_ACQUIRE, "agent");
            xb_add(&bar[XB_XGEN(b.x)], 1u);
            asm volatile("s_waitcnt vmcnt(0)" ::: "memory");
        } else {
            XB_SPIN(xb_ld(&bar[XB_XGEN(b.x)]) == gen, bar);
            __builtin_amdgcn_fence(__ATOMIC_ACQUIRE, "agent");
            asm volatile("s_waitcnt vmcnt(0)" ::: "memory");
        }
    }
    __syncthreads();
}

#define CAS __attribute__((address_space(4)))
struct Args { const float* in[13]; float* out; unsigned char* ws; int ph_lo, ph_hi; };
struct Frame {
    LAS unsigned char* lds;
    int tid, lane, wave, vcu, G, bx;
    const CAS Args* ap;
    float* H;
    bf16_t* hbc; float* sqc;
    unsigned char* ws;
};

struct TrItem { const float* wp; const float* gk; bf16_t* wt; int srcN, K; float sn; };
__device__ __forceinline__ bool p0_decode(Frame& F, int it, int lane, TrItem& t) {
    const float* pool_norm = F.ap->in[1]; const float* pool_w = F.ap->in[2]; const float* pool_scale = F.ap->in[3];
    const float* mlstm_norm = F.ap->in[4]; const float* w_in = F.ap->in[5]; const float* head_norm = F.ap->in[7]; const float* w_out = F.ap->in[8];
    const float* ffn_norm = F.ap->in[9]; const float* ffn_w_in = F.ap->in[10]; const float* ffn_w_out = F.ap->in[11];
    bf16_t* WPOOL = (bf16_t*)(F.ws + WS_WPOOL); bf16_t* WIN = (bf16_t*)(F.ws + WS_WIN); bf16_t* WOUT = (bf16_t*)(F.ws + WS_WOUT);
    bf16_t* WF1 = (bf16_t*)(F.ws + WS_WF1); bf16_t* WF2 = (bf16_t*)(F.ws + WS_WF2);
    constexpr int I_POOL = 8 * 16, I_IN = 2 * 768, I_OUT = 2 * 256, I_F1 = 4 * 1408, I_F2 = 4 * 704;
    constexpr int NITEMS = I_POOL + I_IN + I_OUT + I_F1 + I_F2;
    if (it >= NITEMS) return false;
    int r = it; const float* W; const float* gk; bf16_t* WT; int srcN, K, k0, n0, drow0; float sn = 1.0f;
    if (r < I_F1) { const int i = r / 1408, rr = r % 1408, kb = rr / 88, nb = rr % 88; n0 = 64 * nb; const int jh = n0 % DFF, isup = n0 / DFF;
        W = ffn_w_in + (size_t)i * D * 2 * DFF; srcN = 2 * DFF; K = D; k0 = 64 * kb; gk = ffn_norm + i * D; WT = WF1 + (size_t)i * 2 * DFF * D; drow0 = (jh / 128) * 256 + isup * 128 + (jh % 128); }
    else if ((r -= I_F1) < I_F2) { const int i = r / 704, rr = r % 704, kb = rr / 16, nb = rr % 16; n0 = 64 * nb;
        W = ffn_w_out + (size_t)i * DFF * D; srcN = D; K = DFF; k0 = 64 * kb; gk = nullptr; WT = WF2 + (size_t)i * D * DFF; drow0 = n0; }
    else if ((r -= I_F2) < I_IN) { const int j = r / 768, rr = r % 768, kb = rr / 48, nb = rr % 48; n0 = 64 * nb;
        W = w_in + (size_t)j * D * INW; srcN = INW; K = D; k0 = 64 * kb; gk = mlstm_norm + j * D; sn = (n0 < NH * DQK) ? 0.08838834764831845f : 1.0f; WT = WIN + (size_t)j * INW_MAIN * D; drow0 = n0; }
    else if ((r -= I_IN) < I_OUT) { const int j = r / 256, rr = r % 256, kb = rr / 16, nb = rr % 16; n0 = 64 * nb;
        W = w_out + (size_t)j * D * D; srcN = D; K = D; k0 = 64 * kb; gk = head_norm + j * D; WT = WOUT + (size_t)j * D * D; drow0 = n0; }
    else { r -= I_OUT; const int mat = r / 16, rr = r % 16, kb = rr / 4, nb = rr % 4, j = mat / 4, g = mat % 4; n0 = 64 * nb;
        W = pool_w + (size_t)mat * 65536; srcN = 256; K = 256; k0 = 64 * kb; gk = pool_norm + j * D + g * 256; sn = pool_scale[j * D + g * 256 + n0 + lane]; WT = WPOOL + (size_t)j * D * 256; drow0 = g * 256 + n0; }
    t.wp = W + (size_t)k0 * srcN + n0 + lane; t.gk = gk ? gk + k0 : nullptr; t.wt = WT + (size_t)drow0 * K + k0; t.srcN = srcN; t.K = K; t.sn = sn;
    return true;
}
#define P0_LOAD(V, GL, T) do { _Pragma("unroll") for (int i_ = 0; i_ < 64; ++i_) V[i_] = (T).wp[(size_t)i_ * (T).srcN]; GL = (T).gk ? (T).gk[lane] : 1.0f; } while (0)
#define P0_FINISH(V, GL, T) do { \
    _Pragma("unroll") for (int i_ = 0; i_ < 64; ++i_) scr[i_ * 65 + lane] = V[i_] * (__builtin_bit_cast(float, __builtin_amdgcn_readlane(__builtin_bit_cast(int, GL), i_)) * (T).sn); \
    LDS_WAIT(); asm volatile("" ::: "memory"); \
    _Pragma("unroll") for (int j_ = 0; j_ < 8; ++j_) { const int n_ = (lane >> 3) + 8 * j_; const LAS float* s_ = scr + (8 * (lane & 7)) * 65 + n_; \
        u32x4 o_; o_.x = cvt_pk_bf16(s_[0 * 65], s_[1 * 65]); o_.y = cvt_pk_bf16(s_[2 * 65], s_[3 * 65]); o_.z = cvt_pk_bf16(s_[4 * 65], s_[5 * 65]); o_.w = cvt_pk_bf16(s_[6 * 65], s_[7 * 65]); \
        *(u32x4*)((T).wt + (size_t)n_ * (T).K + 8 * (lane & 7)) = o_; } \
    LDS_WAIT(); asm volatile("" ::: "memory"); } while (0)
__device__ __forceinline__ int stage_count(int st) { return st == 0 ? 3264 : (st == 3 ? 704 + 1408 + 256 : 704 + 1408 + 384); }
__device__ __forceinline__ int stage_item(int st, int i) {
    if (st == 0) { if (i < 1408) return i; i -= 1408; if (i < 704) return 5632 + i; i -= 704; if (i < 768) return 8448 + i; i -= 768; if (i < 256) return 9984 + i; i -= 256; return 10496 + i; }
    if (i < 704) return 5632 + 704 * st + i; i -= 704;
    if (i < 1408) return 1408 * st + i; i -= 1408;
    if (st == 1) return 9216 + i; if (st == 2) return 9600 + i;
    return 10240 + i;
}
__device__ __forceinline__ void p0_run_items(Frame& F, int st, int worker, int nworkers) {
    LAS float* scr = (LAS float*)(F.lds + F.wave * 16640);
    const int lane = F.lane, cnt = stage_count(st);
    TrItem tA, tB; float vA[64], vB[64], gA, gB;
    int i = worker; bool hasA = (i < cnt) && p0_decode(F, stage_item(st, i), lane, tA), hasB;
    if (hasA) P0_LOAD(vA, gA, tA);
    while (hasA) {
        i += nworkers; hasB = (i < cnt) && p0_decode(F, stage_item(st, i), lane, tB); if (hasB) P0_LOAD(vB, gB, tB);
        P0_FINISH(vA, gA, tA);
        if (!hasB) break;
        i += nworkers; hasA = (i < cnt) && p0_decode(F, stage_item(st, i), lane, tA); if (hasA) P0_LOAD(vA, gA, tA);
        P0_FINISH(vB, gB, tB);
    }
}
__device__ __forceinline__ void p0_prologue(Frame& F) {
    const int gw = F.vcu * NWAVES + F.wave, NGW = F.G * NWAVES, lane = F.lane;
    const float* mlstm_norm = F.ap->in[4]; const float* w_in = F.ap->in[5];
    { const float* x = F.ap->in[0]; float* SSQ = (float*)(F.ws + WS_SSQ); bf16_t* XB = (bf16_t*)(F.ws + WS_HB2);
      for (int m0 = gw * 4; m0 < M; m0 += NGW * 4) { f32x4 v[4][4];
#pragma unroll
          for (int r = 0; r < 4; ++r)
#pragma unroll
              for (int j = 0; j < 4; ++j) v[r][j] = *((const f32x4*)(x + (size_t)(m0 + r) * D) + lane + 64 * j);
#pragma unroll
          for (int r = 0; r < 4; ++r)
#pragma unroll
              for (int j = 0; j < 4; ++j) { u32x2 w; w.x = cvt_pk_bf16(v[r][j].x, v[r][j].y); w.y = cvt_pk_bf16(v[r][j].z, v[r][j].w); *(u32x2*)(XB + (size_t)(m0 + r) * D + 4 * (lane + 64 * j)) = w; }
#pragma unroll
          for (int r = 0; r < 4; ++r) { float s2 = 0.f;
#pragma unroll
              for (int j = 0; j < 4; ++j) s2 += (v[r][j].x * v[r][j].x + v[r][j].y * v[r][j].y) + (v[r][j].z * v[r][j].z + v[r][j].w * v[r][j].w);
              s2 = wave_sum(s2, lane); if (lane == 0) *(f32x4*)(SSQ + (size_t)(m0 + r) * 4) = (f32x4){s2, 0.f, 0.f, 0.f}; } } }
    { bf16_t* WGB = (bf16_t*)(F.ws + WS_WGB); const int gt = F.vcu * NTHREADS + F.tid;
      if (gt < 2 * 16 * D) { const int j = gt / (16 * D), n = (gt / D) % 16, k = gt % D;
          const float v = (n < 8) ? w_in[(size_t)j * D * INW + (size_t)k * INW + INW_MAIN + n] * mlstm_norm[j * D + k] : 0.f;
          WGB[gt] = (bf16_t)(cvt_pk_bf16(v, 0.f) & 0xffffu); } }
}
#undef P0_LOAD
#undef P0_FINISH

template <int WIN>
__device__ __forceinline__ void pool_prep_unit_w(Frame& F, const float* xf, int pm, int g) {
    const int tid = F.tid, seg = F.wave, cq = F.lane, col = g * 256 + 4 * cq;
    const float* SSQ = F.sqc; const bf16_t* hb = F.hbc;
    LAS float* rinv = (LAS float*)(F.lds + PA_RINV_OFF);
    LAS unsigned char* At = F.lds + (cq >> 3) * PA_BLK + ((cq >> 1) & 3) * PA_LG + (cq & 1) * 8;
    const int r0 = pm * 256, tp0 = r0 % SEQ;
    const int first = 32 * seg;
    u32x2 rp[16], rc[2][16];
    const __amdgpu_buffer_rsrc_t rH = __builtin_amdgcn_make_buffer_rsrc((void*)hb, 0, 0x7fffffff, 0x00020000);
    const unsigned voh = (unsigned)(col * 2);
#pragma unroll
    for (int i = 0; i < 16; ++i) { const int rl = first - 16 + i; rp[i] = (u32x2){0u, 0u};
        if (tp0 + rl >= 0) rp[i] = __builtin_amdgcn_raw_buffer_load_b64(rH, voh, (unsigned)((r0 + rl) * D * 2), 0); }
#pragma unroll
    for (int i = 0; i < 16; ++i) rc[0][i] = __builtin_amdgcn_raw_buffer_load_b64(rH, voh, (unsigned)((r0 + first + i) * D * 2), 0);
    __syncthreads();
    if (tid < 272) { const int tp = tp0 - 16 + tid; rinv[tid] = (tp >= 0) ? rinv_of(*(const f32x4*)(SSQ + (size_t)(r0 - 16 + tid) * 4)) : 0.f; }
    __syncthreads();
#pragma unroll
    for (int i = 0; i < 16; ++i) rc[1][i] = __builtin_amdgcn_raw_buffer_load_b64(rH, voh, (unsigned)((r0 + first + 16 + i) * D * 2), 0);
    f32x4 prev[16], cur[16];
#pragma unroll
    for (int i = 0; i < 16; ++i) { const int rl = first - 16 + i;
        const u32x2 h = rp[i]; prev[i] = (f32x4){bflo(h.x), bfhi(h.x), bflo(h.y), bfhi(h.y)} * rinv[16 + rl]; }
    f32x4 S = {0.f, 0.f, 0.f, 0.f};
#pragma unroll
    for (int i = 16 - WIN; i < 16; ++i) S += prev[i];
#pragma unroll
    for (int blk = 0; blk < 2; ++blk) {
#pragma unroll
        for (int i = 0; i < 16; ++i) { const int rl = first + 16 * blk + i; const u32x2 h = rc[blk][i];
            cur[i] = (f32x4){bflo(h.x), bfhi(h.x), bflo(h.y), bfhi(h.y)} * rinv[16 + rl]; }
#pragma unroll
        for (int i = 0; i < 16; ++i) { const int rl = first + 16 * blk + i, tp = tp0 + rl;
            S += cur[i]; S -= (i - WIN >= 0) ? cur[(i - WIN >= 0) ? i - WIN : 0] : prev[(i - WIN >= 0) ? 0 : 16 + i - WIN];
            const float ic = __builtin_amdgcn_rcpf((float)((tp + 1 < WIN) ? (tp + 1) : WIN));
            const f32x4 o = S * ic - cur[i];
            u32x2 w; w.x = cvt_pk_bf16(o[0], o[1]); w.y = cvt_pk_bf16(o[2], o[3]);
            *(LAS u32x2*)(At + (rl >> 4) * (8 * PA_BLK) + (rl & 15) * 16) = w; }
#pragma unroll
        for (int i = 0; i < 16; ++i) prev[i] = cur[i];
    }
    __syncthreads();
}
__device__ __forceinline__ void pool_prep_unit(Frame& F, const float* xf, int pm, int g) {
    if (g == 0) pool_prep_unit_w<2>(F, xf, pm, g); else if (g == 1) pool_prep_unit_w<4>(F, xf, pm, g); else if (g == 2) pool_prep_unit_w<8>(F, xf, pm, g); else pool_prep_unit_w<16>(F, xf, pm, g);
}

__device__ __forceinline__ void gates_part(Frame& F, int j) {
    const bf16_t* HBp = F.hbc; const bf16_t* WGB = (const bf16_t*)(F.ws + WS_WGB) + (size_t)j * 16 * D; const float* SSQ = F.sqc;
    const float* gbias = F.ap->in[6] + j * 8; float* GI = (float*)(F.ws + WS_GI); float* GF = (float*)(F.ws + WS_GF);
    const int lane = F.lane, lr = lane & 15, lg = lane >> 4;
    const int wb = F.wave & 3, kh = F.wave >> 2;
    const int blk = ((F.bx & 7) * 8 + ((F.bx >> 3) & 7)) * 16 + (F.bx >> 6) * 4 + wb;
    const int row0 = blk * 16, rowa = row0 + 4 * lg;
    const bf16_t* ap = HBp + (size_t)(row0 + lr) * D + 8 * lg + 512 * kh; const bf16_t* bp = WGB + (size_t)lr * D + 8 * lg + 512 * kh;
    f32x4 sq[4];
#pragma unroll
    for (int r = 0; r < 4; ++r) sq[r] = *(const f32x4*)(SSQ + (size_t)(rowa + r) * 4);
    const float bias = gbias[lr & 7];
    bf16x8 av[16], bv[16];
#pragma unroll
    for (int ks = 0; ks < 16; ++ks) { av[ks] = *(const bf16x8*)(ap + 32 * ks); bv[ks] = *(const bf16x8*)(bp + 32 * ks); }
    __builtin_amdgcn_sched_barrier(0);
    f32x4 acc = {0.f, 0.f, 0.f, 0.f};
#pragma unroll
    for (int ks = 0; ks < 16; ++ks) acc = __builtin_amdgcn_mfma_f32_16x16x32_bf16(av[ks], bv[ks], acc, 0, 0, 0);
    LAS f32x4* X = (LAS f32x4*)(F.lds + XPOSE_OFF);
    if (kh == 1) X[wb * 64 + lane] = acc;
    __syncthreads();
    if (kh == 0 && lr < 8) {
        acc += X[wb * 64 + lane];
        const int bb = rowa / SEQ, t = rowa % SEQ;
        f32x4 o;
#pragma unroll
        for (int r = 0; r < 4; ++r) { const float val = acc[r] * rinv_of(sq[r]) + bias;
            o[r] = (lr < 4) ? val : ((val > 0.f) ? -__logf(1.0f + __expf(-val)) : (val - __logf(1.0f + __expf(val)))); }
        *(f32x4*)(((lr < 4) ? GI : GF) + (size_t)(bb * NH + (lr & 3)) * SEQ + t) = o;
    }
}

__device__ __forceinline__ float wave_incl_add(float v, int lane) {
#pragma unroll
    for (int o = 1; o < 64; o <<= 1) { const float t = lane_get(v, lane - o); if (lane >= o) v += t; }
    return v;
}
__device__ __forceinline__ float wave_incl_max(float v, int lane) {
#pragma unroll
    for (int o = 1; o < 64; o <<= 1) { const float t = lane_get(v, lane - o); if (lane >= o) v = fmaxf(v, t); }
    return v;
}
__device__ __forceinline__ bf16x8 pack8(const float (&v)[8]) {
    u32x4 w; w.x = cvt_pk_bf16(v[0], v[1]); w.y = cvt_pk_bf16(v[2], v[3]); w.z = cvt_pk_bf16(v[4], v[5]); w.w = cvt_pk_bf16(v[6], v[7]);
    return __builtin_bit_cast(bf16x8, w);
}
typedef __amdgpu_buffer_rsrc_t rsrc_t;
__device__ __forceinline__ rsrc_t mk_rsrc(const void* p) { return __builtin_amdgcn_make_buffer_rsrc((void*)p, 0, 0x7fffffff, 0x00020000); }
__device__ __forceinline__ bf16x8 bld128(rsrc_t r, unsigned voff, unsigned soff) { return __builtin_bit_cast(bf16x8, __builtin_amdgcn_raw_buffer_load_b128(r, voff, soff, 0)); }
__device__ __forceinline__ u32x2 bld64(rsrc_t r, unsigned voff, unsigned soff) { return __builtin_amdgcn_raw_buffer_load_b64(r, voff, soff, 0); }
__device__ __forceinline__ void bst64(rsrc_t r, u32x2 v, unsigned voff, unsigned soff) { __builtin_amdgcn_raw_buffer_store_b64(v, r, voff, soff, 0); }
__device__ __forceinline__ void wst32(rsrc_t r, float v, unsigned voff, unsigned soff) { __builtin_amdgcn_raw_buffer_store_b32(__float_as_uint(v), r, voff, soff, 16); }
__device__ __forceinline__ void wst64(rsrc_t r, u32x2 v, unsigned voff, unsigned soff) { __builtin_amdgcn_raw_buffer_store_b64(v, r, voff, soff, 16); }
__device__ __forceinline__ void wst128(rsrc_t r, f32x4 v, unsigned voff, unsigned soff) { __builtin_amdgcn_raw_buffer_store_b128(__builtin_bit_cast(u32x4, v), r, voff, soff, 16); }
__device__ __forceinline__ void stream_arrive(Frame& F, unsigned* cnt) {
    asm volatile("s_waitcnt vmcnt(0)" ::: "memory");
    __syncthreads();
    if (F.tid == 0) __hip_atomic_fetch_add(cnt, 1u, __ATOMIC_RELAXED, __HIP_MEMORY_SCOPE_AGENT);
}
__device__ __forceinline__ void stream_wait(Frame& F, unsigned* cnt, unsigned need) {
    if (F.tid == 0) {
        unsigned spins = 0;
        while (__hip_atomic_load(cnt, __ATOMIC_RELAXED, __HIP_MEMORY_SCOPE_AGENT) < need) { __builtin_amdgcn_s_sleep(1); if (++spins > (1u << 22)) break; }
        __builtin_amdgcn_fence(__ATOMIC_ACQUIRE, "agent");
        asm volatile("s_waitcnt vmcnt(0)" ::: "memory");
    }
    __syncthreads();
}

__device__ __forceinline__ void pool_gemm(Frame& F, const bf16_t* Wt  , int g, f32x4 (&acc)[2][2][4][2]) {
    const int lane = F.lane, wid = F.wave, wr = wid >> 2, wc = wid & 3, fr = lane & 15, fq = lane >> 4;
#pragma unroll
    for (int a = 0; a < 2; ++a)
#pragma unroll
        for (int b = 0; b < 2; ++b)
#pragma unroll
            for (int m = 0; m < 4; ++m)
#pragma unroll
                for (int n = 0; n < 2; ++n) acc[a][b][m][n] = (f32x4){0.f, 0.f, 0.f, 0.f};
    const rsrc_t rW = mk_rsrc(Wt);
    const unsigned vob = (unsigned)(((g * 256 + 32 * wc + 8 * (fr >> 2) + (fr & 3)) * 256 + 8 * fq) * 2);
    const LAS unsigned char* ap = F.lds + (4 * wr) * (8 * PA_BLK) + fq * PA_LG + fr * 16;
    bf16x8 bfr[2][2], bnx[2][2], bn2[2][2];
#pragma unroll
    for (int bj = 0; bj < 2; ++bj)
#pragma unroll
        for (int n = 0; n < 2; ++n) { bfr[bj][n] = bld128(rW, vob, (unsigned)(((128 * bj + 4 * n) * 256) * 2)); bnx[bj][n] = bld128(rW, vob, (unsigned)(((128 * bj + 4 * n) * 256 + 32) * 2)); }
#pragma unroll
    for (int ks = 0; ks < 8; ++ks) {
        if (ks < 6) {
#pragma unroll
            for (int bj = 0; bj < 2; ++bj)
#pragma unroll
                for (int n = 0; n < 2; ++n) bn2[bj][n] = bld128(rW, vob, (unsigned)(((128 * bj + 4 * n) * 256 + 32 * (ks + 2)) * 2));
        }
#pragma unroll
        for (int ai = 0; ai < 2; ++ai)
#pragma unroll
            for (int m = 0; m < 4; ++m) { const bf16x8 af = *(const LAS bf16x8*)(ap + ((8 * ai + m) * 8 + ks) * PA_BLK);
#pragma unroll
                for (int bj = 0; bj < 2; ++bj)
#pragma unroll
                    for (int n = 0; n < 2; ++n) acc[ai][bj][m][n] = __builtin_amdgcn_mfma_f32_16x16x32_bf16(bfr[bj][n], af, acc[ai][bj][m][n], 0, 0, 0); }
#pragma unroll
        for (int bj = 0; bj < 2; ++bj)
#pragma unroll
            for (int n = 0; n < 2; ++n) { bfr[bj][n] = bnx[bj][n]; bnx[bj][n] = bn2[bj][n]; }
        __builtin_amdgcn_sched_barrier(0);
    }
}

__device__ __forceinline__ void scan1_phase(Frame& F, unsigned* c1) {
    const float* GI = (const float*)(F.ws + WS_GI); const float* GF = (const float*)(F.ws + WS_GF);
    float* TA = (float*)(F.ws + WS_TA); float* TM = (float*)(F.ws + WS_TM); float* TB = (float*)(F.ws + WS_TB); float* MPREV = (float*)(F.ws + WS_MPREV); float* DEC = (float*)(F.ws + WS_DEC);
    const rsrc_t rQ = mk_rsrc(F.H), rVT = mk_rsrc(F.ws + WS_VT), rLOC = mk_rsrc(F.ws + WS_LOC);
    const rsrc_t rTA = mk_rsrc(TA), rTM = mk_rsrc(TM), rTB = mk_rsrc(TB), rMP = mk_rsrc(MPREV), rDEC = mk_rsrc(DEC), rLN = mk_rsrc(F.ws + WS_LOCN);
    LAS float* TAs = (LAS float*)F.lds;
    LAS float* CMs = TAs + 4096;
    LAS float* BCs = CMs + 4096; LAS float* ACs = BCs + 16; LAS float* MPs = ACs + 16; LAS float* MEs = MPs + 16;
    LAS float* WT = (LAS float*)(F.lds + XPOSE_OFF);
    LAS unsigned char* VF = F.lds;
    LAS unsigned char* KS = F.lds + 56 * 1024;
    const int lane = F.lane, wid = F.wave, tid = F.tid, lr = lane & 15, lg = lane >> 4;
    for (int wg = F.bx; wg < NSTREAM * NCH; wg += F.G) {
        const int x_ = wg & 7, of_ = wg >> 3, bb_ = x_ >> 1, c = 8 * (x_ & 1) + (of_ & 7), stream = 4 * bb_ + (of_ >> 3), pub = (c == 0);
        if (c >= NCH - 1) continue;
        const int unit = stream * (NCH - 1) + c;
        const unsigned voff = (unsigned)(lr * (SEQ * 2) + lg * 16);
        bf16x8 vt[16], kf[8]; u32x4 kr[8];
#pragma unroll
        for (int i = 0; i < 16; ++i) { const int vb = 2 * wid + (i >> 3), ks = i & 7; vt[i] = bld128(rVT, voff, (unsigned)(((stream * DV + 16 * vb) * SEQ + c * LC + 32 * ks) * 2)); }
#pragma unroll
        for (int i = 0; i < 8; ++i) kr[i] = __builtin_amdgcn_raw_buffer_load_b128(rQ, (unsigned)((tid >> 4) * 4096 + (tid & 15) * 16), (unsigned)(((bb_ * SEQ + c * LC + 32 * i) * 2048 + NH * DQK + (of_ >> 3) * DQK) * 2), 0);
        __syncthreads();
        for (int cc = 0; cc < 2; ++cc) {
            const int ch = wid + 8 * cc; const size_t base = (size_t)stream * SEQ + ch * LC + 4 * lane;
            const f32x4 f = *(const f32x4*)(GF + base), ii = *(const f32x4*)(GI + base);
            const float p0 = f.x, p1 = p0 + f.y, p2 = p1 + f.z, p3 = p2 + f.w;
            const float incl = wave_incl_add(p3, lane), excl = incl - p3;
            const float b0 = excl + p0, b1 = excl + p1, b2 = excl + p2, b3 = excl + p3;
            const float a0 = ii.x - b0, a1 = ii.y - b1, a2 = ii.z - b2, a3 = ii.w - b3;
            const float q0 = a0, q1 = fmaxf(q0, a1), q2 = fmaxf(q1, a2), q3 = fmaxf(q2, a3);
            const float im = wave_incl_max(q3, lane); float exm = lane_get(im, lane - 1); if (lane == 0) exm = -INFINITY;
            const f32x4 cm = {fmaxf(exm, q0), fmaxf(exm, q1), fmaxf(exm, q2), fmaxf(exm, q3)};
            *(LAS f32x4*)(TAs + ch * LC + 4 * lane) = (f32x4){a0, a1, a2, a3};
            *(LAS f32x4*)(CMs + ch * LC + 4 * lane) = cm;
            if (pub) wst128(rTB, (f32x4){b0, b1, b2, b3}, (unsigned)(lane * 16), (unsigned)((stream * SEQ + ch * LC) * 4));
            if (lane == 63) { BCs[ch] = b3; ACs[ch] = cm.w; }
        }
        __syncthreads();
        if (tid == 0) { float m = 0.f; for (int ch = 0; ch < NCH; ++ch) { MPs[ch] = m; const float me = fmaxf(m, ACs[ch]); MEs[ch] = me; m = BCs[ch] + me; } }
        __syncthreads();
        if (pub) { for (int s2 = tid; s2 < SEQ; s2 += NTHREADS) { wst32(rTA, TAs[s2], (unsigned)(s2 * 4), (unsigned)(stream * SEQ * 4)); wst32(rTM, fmaxf(MPs[s2 >> 8], CMs[s2]), (unsigned)(s2 * 4), (unsigned)(stream * SEQ * 4)); }
                   if (tid < NCH) { wst32(rMP, MPs[tid], (unsigned)(tid * 4), (unsigned)(stream * NCH * 4)); wst32(rDEC, __expf(MPs[tid] - MEs[tid]), (unsigned)(tid * 4), (unsigned)(stream * NCH * 4)); } }
        if (tid < LC) WT[tid] = __expf(TAs[c * LC + tid] - MEs[c]);
#pragma unroll
        for (int i = 0; i < 8; ++i) *(LAS u32x4*)(KS + (32 * i + (tid >> 4)) * 288 + (tid & 15) * 16) = kr[i];
        __syncthreads();
        {
            typedef short v4s __attribute__((ext_vector_type(4)));
            const LAS unsigned char* kp = KS + (8 * lg + (lr >> 2)) * 288 + (16 * wid + 4 * (lr & 3)) * 2;
#pragma unroll
            for (int ks = 0; ks < 8; ++ks) {
                const v4s lo = __builtin_amdgcn_ds_read_tr16_b64_v4i16((LAS v4s*)(kp + (32 * ks) * 288)), hi = __builtin_amdgcn_ds_read_tr16_b64_v4i16((LAS v4s*)(kp + (32 * ks + 4) * 288));
                kf[ks] = (bf16x8){lo[0], lo[1], lo[2], lo[3], hi[0], hi[1], hi[2], hi[3]}; }
        }
        __syncthreads();
        {
#pragma unroll
          for (int i = 0; i < 16; ++i) { const int vb = 2 * wid + (i >> 3), ks = i & 7; *(LAS bf16x8*)(VF + (vb * 8 + ks) * 1024 + lane * 16) = vt[i]; }
          __syncthreads();
          f32x4 acc[16], accn = {0.f, 0.f, 0.f, 0.f};
#pragma unroll
          for (int vb = 0; vb < 16; ++vb) acc[vb] = (f32x4){0.f, 0.f, 0.f, 0.f};
          bf16x8 ones; { const short o1 = (short)0x3F80;
#pragma unroll
              for (int e = 0; e < 8; ++e) ones[e] = o1; }
#pragma unroll
          for (int ks = 0; ks < 8; ++ks) {
              const f32x4 w0 = *(const LAS f32x4*)(WT + 32 * ks + 8 * lg), w1 = *(const LAS f32x4*)(WT + 32 * ks + 8 * lg + 4);
              float sc[8];
#pragma unroll
              for (int e = 0; e < 4; ++e) { sc[e] = bf2f((unsigned short)kf[ks][e]) * w0[e]; sc[4 + e] = bf2f((unsigned short)kf[ks][4 + e]) * w1[e]; }
              const bf16x8 af = pack8(sc);
#pragma unroll
              for (int vb = 0; vb < 16; ++vb) acc[vb] = __builtin_amdgcn_mfma_f32_16x16x32_bf16(af, *(const LAS bf16x8*)(VF + (vb * 8 + ks) * 1024 + lane * 16), acc[vb], 0, 0, 0);
              accn = __builtin_amdgcn_mfma_f32_16x16x32_bf16(af, ones, accn, 0, 0, 0);
          }
          const unsigned vol = (unsigned)(lr * (DQK * 2) + lg * 8);
#pragma unroll
          for (int vb = 0; vb < 16; ++vb) { u32x2 w; w.x = cvt_pk_bf16(acc[vb][0], acc[vb][1]); w.y = cvt_pk_bf16(acc[vb][2], acc[vb][3]);
              wst64(rLOC, w, vol, (unsigned)(((unit * DV + 16 * vb) * DQK + 16 * wid) * 2)); }
          if (lr == 0) wst128(rLN, accn, (unsigned)(lg * 16), (unsigned)((unit * DQK + 16 * wid) * 4));
        }
        stream_arrive(F, c1 + stream * 16);
    }
}
__device__ __forceinline__ void scan2_phase(Frame& F, unsigned* c1, unsigned* c2) {
    const bf16_t* LOC = (const bf16_t*)(F.ws + WS_LOC); const float* LOCN = (const float*)(F.ws + WS_LOCN); const float* DEC = (const float*)(F.ws + WS_DEC);
    const rsrc_t rCST = mk_rsrc(F.ws + WS_CST), rNST = mk_rsrc(F.ws + WS_NST);
    for (int wg = F.bx; wg < 256; wg += F.G) {
        const int x_ = wg & 7, i_ = (x_ & 1) * 32 + (wg >> 3), stream = 4 * (x_ >> 1) + (i_ >> 4), sl = i_ & 15, e = (sl * NTHREADS + F.tid) * 4;
        stream_wait(F, c1 + stream * 16, NCH - 1);
        u32x2 Lb[NCH - 1];
#pragma unroll
        for (int c = 0; c < NCH - 1; ++c) Lb[c] = *(const u32x2*)(LOC + ((size_t)(stream * (NCH - 1) + c) * (DV * DQK) + e));
        float z0 = 0.f; asm volatile("" : "+v"(z0));
        f32x4 C = {z0, z0, z0, z0};
#pragma unroll
        for (int c = 0; c < NCH; ++c) {
            u32x2 w; w.x = cvt_pk_bf16(C[0], C[1]); w.y = cvt_pk_bf16(C[2], C[3]);
            wst64(rCST, w, (unsigned)(e * 2), (unsigned)((stream * NCH + c) * (DV * DQK) * 2));
            if (c < NCH - 1) C = C * DEC[stream * NCH + c] + (f32x4){bflo(Lb[c].x), bfhi(Lb[c].x), bflo(Lb[c].y), bfhi(Lb[c].y)};
        }
        if (sl == 0 && F.tid < DQK / 4) {
            const int en = F.tid * 4; float z1 = 0.f; asm volatile("" : "+v"(z1)); f32x4 Cn = {z1, z1, z1, z1};
            f32x4 Ln[NCH - 1]; float dn[NCH - 1];
#pragma unroll
            for (int c = 0; c < NCH - 1; ++c) { Ln[c] = *(const f32x4*)(LOCN + (size_t)(stream * (NCH - 1) + c) * DQK + en); dn[c] = DEC[stream * NCH + c]; }
#pragma unroll
            for (int c = 0; c < NCH; ++c) { wst128(rNST, Cn, (unsigned)(en * 4), (unsigned)((stream * NCH + c) * DQK * 4));
                if (c < NCH - 1) Cn = Cn * dn[c] + Ln[c]; } }
        stream_arrive(F, c2 + stream * 16);
    }
}

__device__ __forceinline__ void out_phase(Frame& F, unsigned* c2) {
    const float* TA = (const float*)(F.ws + WS_TA); const float* TM = (const float*)(F.ws + WS_TM); const float* TB = (const float*)(F.ws + WS_TB);
    const float* MPREV = (const float*)(F.ws + WS_MPREV); const float* NST = (const float*)(F.ws + WS_NST);
    const rsrc_t rQKO = mk_rsrc(F.H), rVT = mk_rsrc(F.ws + WS_VT), rCST = mk_rsrc(F.ws + WS_CST), rHG = mk_rsrc(F.ws + WS_HG);
    LAS float* As = (LAS float*)F.lds; LAS float* Ms = As + LC; LAS float* Bs = Ms + LC; LAS float* RD = Bs + LC; LAS float* RN = RD + LC;
    LAS float* SSp = (LAS float*)(F.lds + 8192);
    LAS unsigned char* QF = F.lds + 16384;
    LAS unsigned char* PF = F.lds + 81920;
    LAS unsigned char* KF = F.lds + 114688;
    const int lane = F.lane, wid = F.wave, tid = F.tid, lr = lane & 15, lg = lane >> 4;
    const unsigned voq = (unsigned)(lr * 4096 + lg * 16), voc = (unsigned)(lr * 256 + lg * 16), vov = (unsigned)(lr * 8192 + lg * 8);
    const unsigned voo = (unsigned)(lr * 4096 + lg * 8), vog = (unsigned)(lr * 2048 + lg * 8);
    for (int unit = F.bx; unit < NSTREAM * NCH; unit += F.G) {
        const int pm_ = 8 * (unit & 7) + ((unit >> 3) & 7), hh = unit >> 6, bb = pm_ >> 4, c = pm_ & 15, stream = 4 * bb + hh;
        const int rowbase = bb * SEQ + c * LC;
        bf16x8 qv[8];
#pragma unroll
        for (int i = 0; i < 8; ++i) { const int blk = wid * 8 + i, tb = blk >> 2, kq = blk & 3;
            qv[i] = bld128(rQKO, voq, (unsigned)(((rowbase + 16 * tb) * 2048 + hh * DQK + 32 * kq) * 2)); }
        const unsigned sKw = (unsigned)(((rowbase + 16 * (wid >> 2)) * 2048 + NH * DQK + hh * DQK + 32 * (wid & 3)) * 2);
        const bf16x8 kv0 = bld128(rQKO, voq, sKw), kv1 = bld128(rQKO, voq, sKw + (unsigned)(32 * 4096));
        stream_wait(F, c2 + stream * 16, NCH);
        float tav = 0.f, tmv = 0.f, tbv = 0.f;
        if (tid < LC) { const size_t o = (size_t)stream * SEQ + c * LC + tid; tav = TA[o]; tmv = TM[o]; tbv = TB[o]; }
        const float mprev = MPREV[stream * NCH + c];
        const float* nst = NST + (size_t)(stream * NCH + c) * DQK;
        const unsigned sC = (unsigned)(((stream * NCH + c) * DV + 32 * wid) * DQK * 2);
        bf16x8 cfr[2][4];
#pragma unroll
        for (int vbi = 0; vbi < 2; ++vbi)
#pragma unroll
            for (int kq = 0; kq < 4; ++kq) cfr[vbi][kq] = bld128(rCST, voc, sC + (unsigned)(16 * vbi * DQK * 2 + 64 * kq));
        f32x4 nq[4][2];
#pragma unroll
        for (int kq = 0; kq < 4; ++kq) { nq[kq][0] = *(const f32x4*)(nst + 32 * kq + 8 * lg); nq[kq][1] = *(const f32x4*)(nst + 32 * kq + 8 * lg + 4); }
        __builtin_amdgcn_sched_barrier(0);
        if (tid < LC) { As[tid] = tav; Ms[tid] = tmv; Bs[tid] = tbv; }
#pragma unroll
        for (int i = 0; i < 8; ++i) *(LAS bf16x8*)(QF + (wid * 8 + i) * 1024 + lane * 16) = qv[i];
        *(LAS bf16x8*)(KF + wid * 1024 + lane * 16) = kv0;
        *(LAS bf16x8*)(KF + 8192 + wid * 1024 + lane * 16) = kv1;
        bf16x8 nfr[4];
#pragma unroll
        for (int kq = 0; kq < 4; ++kq) { float nv[8];
#pragma unroll
            for (int e = 0; e < 4; ++e) { nv[e] = (lr == 0) ? nq[kq][0][e] : 0.f; nv[4 + e] = (lr == 0) ? nq[kq][1][e] : 0.f; }
            nfr[kq] = pack8(nv); }
        __syncthreads();
        f32x4 acc[2][16];
#pragma unroll
        for (int tb = 0; tb < 16; ++tb) {
            f32x4 a0 = {0.f, 0.f, 0.f, 0.f}, a1 = {0.f, 0.f, 0.f, 0.f};
#pragma unroll
            for (int kq = 0; kq < 4; ++kq) { const bf16x8 q = *(const LAS bf16x8*)(QF + (tb * 4 + kq) * 1024 + lane * 16);
                a0 = __builtin_amdgcn_mfma_f32_16x16x32_bf16(cfr[0][kq], q, a0, 0, 0, 0); a1 = __builtin_amdgcn_mfma_f32_16x16x32_bf16(cfr[1][kq], q, a1, 0, 0, 0); }
            const float it = __expf(mprev - Ms[16 * tb + lr]);
            acc[0][tb] = a0 * it; acc[1][tb] = a1 * it;
        }
        float qn[2], Mt[2], dsum[2] = {0.f, 0.f};
#pragma unroll
        for (int o = 0; o < 2; ++o) { const int tb = o ? (15 - wid) : wid; f32x4 an = {0.f, 0.f, 0.f, 0.f};
#pragma unroll
            for (int kq = 0; kq < 4; ++kq) an = __builtin_amdgcn_mfma_f32_16x16x32_bf16(nfr[kq], *(const LAS bf16x8*)(QF + (tb * 4 + kq) * 1024 + lane * 16), an, 0, 0, 0);
            qn[o] = lane_get(an[0], lr); Mt[o] = Ms[16 * tb + lr]; }
        const unsigned sV0 = (unsigned)(((stream * DV + 32 * wid) * SEQ + c * LC) * 2);
        u32x2 vlo[2], vhi[2];
#pragma unroll
        for (int vbi = 0; vbi < 2; ++vbi) { vlo[vbi] = bld64(rVT, vov, sV0 + (unsigned)(16 * vbi * SEQ * 2)); vhi[vbi] = bld64(rVT, vov, sV0 + (unsigned)(16 * vbi * SEQ * 2 + 32)); }
#define OP_PHASE1(kk) do { const LAS unsigned char* kf_ = KF + ((kk) & 1) * 8192; LAS unsigned char* pf_ = PF + ((kk) & 1) * 16384; \
        _Pragma("unroll") for (int o = 0; o < 2; ++o) { const int tb = o ? (15 - wid) : wid; \
            if (tb >= 2 * (kk)) { const int t = 16 * tb + lr; float p[8]; \
                _Pragma("unroll") for (int mb = 0; mb < 2; ++mb) { f32x4 sa = {0.f, 0.f, 0.f, 0.f}; \
                    _Pragma("unroll") for (int kq = 0; kq < 4; ++kq) sa = __builtin_amdgcn_mfma_f32_16x16x32_bf16(*(const LAS bf16x8*)(kf_ + (mb * 4 + kq) * 1024 + lane * 16), *(const LAS bf16x8*)(QF + (tb * 4 + kq) * 1024 + lane * 16), sa, 0, 0, 0); \
                    const int sb = 32 * (kk) + 16 * mb + 4 * lg; const f32x4 av = *(const LAS f32x4*)(As + sb); \
                    _Pragma("unroll") for (int r = 0; r < 4; ++r) { const float d = (sb + r <= t) ? __expf(av[r] - Mt[o]) : 0.f; const float pv = sa[r] * d; p[mb * 4 + r] = pv; dsum[o] += pv; } } \
                *(LAS bf16x8*)(pf_ + tb * 1024 + lane * 16) = pack8(p); } } } while (0)
        OP_PHASE1(0);
#pragma unroll 1
        for (int ks = 0; ks < 8; ++ks) {
            const LAS unsigned char* pf = PF + (ks & 1) * 16384;
            const int k2 = (ks + 2 < 8) ? ks + 2 : 7, kn = (ks < 7) ? ks + 1 : ks;
            const bf16x8 knext = bld128(rQKO, voq, sKw + (unsigned)(32 * k2 * 4096));
            const u32x4 va0 = {vlo[0].x, vlo[0].y, vhi[0].x, vhi[0].y}, va1 = {vlo[1].x, vlo[1].y, vhi[1].x, vhi[1].y};
            const bf16x8 vf0 = __builtin_bit_cast(bf16x8, va0), vf1 = __builtin_bit_cast(bf16x8, va1);
            __syncthreads();
            if (ks < 7) OP_PHASE1(ks + 1);
#pragma unroll
            for (int tb = 0; tb < 16; ++tb) { if (tb >= 2 * ks) { const bf16x8 pp = *(const LAS bf16x8*)(pf + tb * 1024 + lane * 16);
                acc[0][tb] = __builtin_amdgcn_mfma_f32_16x16x32_bf16(vf0, pp, acc[0][tb], 0, 0, 0); acc[1][tb] = __builtin_amdgcn_mfma_f32_16x16x32_bf16(vf1, pp, acc[1][tb], 0, 0, 0); }
                if ((tb & 3) == 3) __builtin_amdgcn_sched_barrier(0); }
#pragma unroll
            for (int vbi = 0; vbi < 2; ++vbi) { vlo[vbi] = bld64(rVT, vov, sV0 + (unsigned)(16 * vbi * SEQ * 2 + 64 * kn)); vhi[vbi] = bld64(rVT, vov, sV0 + (unsigned)(16 * vbi * SEQ * 2 + 64 * kn + 32)); }
            *(LAS bf16x8*)(KF + (ks & 1) * 8192 + wid * 1024 + lane * 16) = knext;
        }
#undef OP_PHASE1
#define OP_GLOAD(OV, tg) do { _Pragma("unroll") for (int i_ = 0; i_ < 4; ++i_) { const unsigned sO_ = (unsigned)(((rowbase + 16 * (4 * (tg) + i_)) * 2048 + 2 * NH * DQK + hh * DV + 32 * wid) * 2); \
            _Pragma("unroll") for (int vbi = 0; vbi < 2; ++vbi) OV[i_][vbi] = bld64(rQKO, voo, sO_ + 32 * vbi); } } while (0)
#define OP_GOUT(OV, tg) do { _Pragma("unroll") for (int i_ = 0; i_ < 4; ++i_) { const int tb = 4 * (tg) + i_; const float rn = RN[16 * tb + lr]; \
            const unsigned sG_ = (unsigned)(((rowbase + 16 * tb) * D + hh * DV + 32 * wid) * 2); \
            _Pragma("unroll") for (int vbi = 0; vbi < 2; ++vbi) { \
                const float o0 = bflo(OV[i_][vbi].x), o1 = bfhi(OV[i_][vbi].x), o2 = bflo(OV[i_][vbi].y), o3 = bfhi(OV[i_][vbi].y); \
                const float g0 = acc[vbi][tb][0] * rn * __builtin_amdgcn_rcpf(1.0f + __expf(-o0)), g1 = acc[vbi][tb][1] * rn * __builtin_amdgcn_rcpf(1.0f + __expf(-o1)); \
                const float g2 = acc[vbi][tb][2] * rn * __builtin_amdgcn_rcpf(1.0f + __expf(-o2)), g3 = acc[vbi][tb][3] * rn * __builtin_amdgcn_rcpf(1.0f + __expf(-o3)); \
                u32x2 w_; w_.x = cvt_pk_bf16(g0, g1); w_.y = cvt_pk_bf16(g2, g3); __builtin_amdgcn_raw_buffer_store_b64(w_, rHG, vog, sG_ + 32 * vbi, 16); } } } while (0)
        u32x2 ovA[4][2], ovB[4][2];
        OP_GLOAD(ovA, 0);
#pragma unroll
        for (int o = 0; o < 2; ++o) { const int tb = o ? (15 - wid) : wid; const int t = 16 * tb + lr;
            float ds = dsum[o]; ds += lane_xor(ds, 16, lane); ds += lane_xor(ds, 32, lane);
            const float den = __expf(mprev - Mt[o]) * qn[o] + ds;
            if (lg == 0) RD[t] = __builtin_amdgcn_rcpf(fmaxf(fabsf(den), __expf(-(Bs[t] + Mt[o])))); }
        __syncthreads();
#pragma unroll
        for (int tb = 0; tb < 16; ++tb) { const float rd = RD[16 * tb + lr];
            acc[0][tb] *= rd; acc[1][tb] *= rd;
            float ss = (acc[0][tb][0] * acc[0][tb][0] + acc[0][tb][1] * acc[0][tb][1]) + (acc[0][tb][2] * acc[0][tb][2] + acc[0][tb][3] * acc[0][tb][3])
                     + (acc[1][tb][0] * acc[1][tb][0] + acc[1][tb][1] * acc[1][tb][1]) + (acc[1][tb][2] * acc[1][tb][2] + acc[1][tb][3] * acc[1][tb][3]);
            ss += lane_xor(ss, 16, lane); ss += lane_xor(ss, 32, lane);
            if (lg == 0) SSp[wid * LC + 16 * tb + lr] = ss; }
        __syncthreads();
        if (tid < LC) { float ss = 0.f;
#pragma unroll
            for (int w = 0; w < 8; ++w) ss += SSp[w * LC + tid];
            RN[tid] = __builtin_amdgcn_rsqf(ss * (1.0f / DV) + EPS); }
        __syncthreads();
        OP_GLOAD(ovB, 1); __builtin_amdgcn_sched_barrier(0); OP_GOUT(ovA, 0); __builtin_amdgcn_sched_barrier(0);
        OP_GLOAD(ovA, 2); __builtin_amdgcn_sched_barrier(0); OP_GOUT(ovB, 1); __builtin_amdgcn_sched_barrier(0);
        OP_GLOAD(ovB, 3); __builtin_amdgcn_sched_barrier(0); OP_GOUT(ovA, 2); __builtin_amdgcn_sched_barrier(0);
        OP_GOUT(ovB, 3);
#undef OP_GLOAD
#undef OP_GOUT
    }
}

__device__ __forceinline__ void fill_rinv_tables(Frame& F, const pg8::StaticOrder& S) {
    const float* SSQ = F.sqc; LAS float* rl = (LAS float*)(F.lds + RINVL_OFF);
    __syncthreads();
    pg8::Unit u; int n = 0, pm0 = 0; bool same = true;
    for (int i = 0; i < 8 && S.next(i, u); ++i) { if (i == 0) pm0 = u.pm; else same = same && (u.pm == pm0); n = i + 1; }
    if (F.tid < 256) {
        if (same) { const float r = rinv_of(*(const f32x4*)(SSQ + (size_t)(pm0 * 256 + F.tid) * 4)); for (int i = 0; i < n; ++i) rl[i * 256 + F.tid] = r; }
        else { for (int i = 0; i < 8 && S.next(i, u); ++i) rl[i * 256 + F.tid] = rinv_of(*(const f32x4*)(SSQ + (size_t)(u.pm * 256 + F.tid) * 4)); }
    }
    __syncthreads();
}

__device__ __forceinline__ void team_barrier(Frame& F, unsigned* cnt) {
    asm volatile("s_waitcnt vmcnt(0)" ::: "memory");
    __syncthreads();
    if (F.tid == 0) {
        __hip_atomic_fetch_add(cnt, 1u, __ATOMIC_RELAXED, __HIP_MEMORY_SCOPE_AGENT);
        unsigned spins = 0;
        while (__hip_atomic_load(cnt, __ATOMIC_RELAXED, __HIP_MEMORY_SCOPE_AGENT) < 4u) { __builtin_amdgcn_s_sleep(1); if (++spins > (1u << 22)) break; }
        __builtin_amdgcn_fence(__ATOMIC_ACQUIRE, "agent");
        asm volatile("s_waitcnt vmcnt(0)" ::: "memory");
    }
    __syncthreads();
}

__global__ void __launch_bounds__(NTHREADS, 2) mk_fwd(Args args_unused) {
    extern __shared__ __attribute__((aligned(16))) unsigned char lds_raw[];
    {
        LAS unsigned char* l0 = (LAS unsigned char*)lds_raw;
        for (int u = threadIdx.x; u < (LDS_BYTES - LDSCTL_OFF) / 4; u += NTHREADS) ((LAS unsigned*)(l0 + LDSCTL_OFF))[u] = 0u;
        __syncthreads();
    }
    const int wave0 = __builtin_amdgcn_readfirstlane((int)(threadIdx.x >> 6));
    int lo, hi;
    { const CAS Args* ap0 = (const CAS Args*)__builtin_amdgcn_kernarg_segment_ptr(); lo = ap0->ph_lo; hi = ap0->ph_hi; }
    XcdBarrier bar; bar.bar = nullptr; bar.x = 0; bar.st = nullptr;
    if (hi - lo > 1) { const CAS Args* ap0 = (const CAS Args*)__builtin_amdgcn_kernarg_segment_ptr();
        bar = xcd_barrier_post((unsigned*)(ap0->ws + WS_CTL) + CW_BAR, (volatile LAS unsigned*)((LAS unsigned char*)lds_raw + MISC_OFF) + 8); }
    int rep = 0;
#pragma unroll 1
    for (int ph = lo; ph < hi; ) {
        unsigned long long apv = (unsigned long long)__builtin_amdgcn_kernarg_segment_ptr(); asm volatile("" : "+s"(apv));
        const CAS Args* ap = (const CAS Args*)apv;
        int wv = wave0; asm volatile("" : "+s"(wv));
        unsigned ones32 = ~0u; asm volatile("" : "+s"(ones32));
        int lanev = (int)__builtin_amdgcn_mbcnt_hi(ones32, __builtin_amdgcn_mbcnt_lo(ones32, 0u)); asm volatile("" : "+v"(lanev));
        const int tidv = wv * 64 + lanev;
        Frame F;
        F.lds = (LAS unsigned char*)lds_raw;
        F.tid = tidv; F.lane = lanev; F.wave = wv;
        { int gdim = gridDim.x, bx = blockIdx.x; asm volatile("" : "+s"(gdim), "+s"(bx)); F.G = gdim; F.bx = bx; F.vcu = (bx & 7) * (gdim >> 3) + (bx >> 3); }
        F.ap = ap; F.H = ap->out; F.ws = ap->ws;
        struct { unsigned char* ws; } args; args.ws = F.ws;
        int layer = 0, pos = 0, kind;
        if (ph == 0) kind = 0;
        else {
            const int q = ph - 1;
            if (q < 3) { layer = 0; pos = q; } else if (q < 10) { layer = 1; pos = q - 3; } else if (q < 13) { layer = 2; pos = q - 10; } else { layer = 3; pos = q - 13; }
            if ((layer & 1) == 0) kind = (pos == 0) ? 2 : (pos == 1) ? 3 : 4;
            else kind = (pos == 0) ? 5 : (pos == 1) ? 6 : (pos == 2) ? 9 : (pos == 3) ? 7 : (pos == 4) ? 2 : (pos == 5) ? 3 : 4;
        }
        const int jl = layer >> 1;
        const bool second = (layer >= 2);
        const bool poolph = (kind == 2 && (layer & 1) == 0);
        bf16_t* const HBa = (bf16_t*)(args.ws + WS_HB); bf16_t* const HBb = (bf16_t*)(args.ws + WS_HB2);
        float* const SQa = (float*)(args.ws + WS_SSQ); float* const SQb = (float*)(args.ws + WS_SSQ2);
        bf16_t* HB = second ? HBb : HBa; float* SSQ = second ? SQa : SQb;
        F.hbc = poolph ? (second ? HBa : HBb) : HB; F.sqc = poolph ? (second ? SQb : SQa) : SSQ;
        if (kind == 0) { if (PH_ON(0)) p0_prologue(F); }
        else if (kind == 2 || kind == 4) {
            pg8::Gemm g; pg8::StaticOrder S; S.init(M, D, F.G, F.bx);
            const float* basef = nullptr;
            if (kind == 4) { g.A = (const bf16_t*)(args.ws + WS_HID); g.Bt = (const bf16_t*)(args.ws + WS_WF2) + (size_t)layer * D * DFF; g.lda = DFF; g.K = DFF; g.grouped = 0; }
            else if ((layer & 1) == 0) { g.A = nullptr; g.Bt = nullptr; g.lda = D; g.K = 256; g.grouped = 1; }
            else { g.A = (const bf16_t*)(args.ws + WS_HG); g.Bt = (const bf16_t*)(args.ws + WS_WOUT) + (size_t)jl * D * D; g.lda = D; g.K = D; g.grouped = 0; }
            const bool lastf2 = (kind == 4 && layer == DEPTH - 1);
            const bool probe_pass = rep < ((kind == PROBE_KIND || (PROBE_KIND == 12 && kind == 2 && (layer & 1)) || (PROBE_KIND == 13 && kind == 2 && !(layer & 1))) ? PROBE_REP : 0);
            const bool pref = (basef == nullptr);
            pg8::EpiResid E{basef, F.hbc, probe_pass ? (bf16_t*)(args.ws + WS_HG) : HB, probe_pass ? (float*)(args.ws + WS_SSQ2 + 512 * 1024) : SSQ, pref, lastf2 ? F.ap->in[12] : nullptr, F.H, (unsigned*)(args.ws + WS_CTL) + CW_PANEL};
            if (kind == 2 && (layer & 1) == 0) {
                pg8::Unit u0;
                if (S.next(0, u0)) {
                    pool_prep_unit(F, basef, u0.pm, u0.pn);
                    f32x4 pacc[2][2][4][2];
                    pool_gemm(F, (const bf16_t*)(args.ws + WS_WPOOL) + (size_t)jl * D * 256, u0.pn, pacc);
                    __syncthreads();
                    E.lds_base = false;
                    E.fused(pacc, u0, F.wave >> 2, F.wave & 3, F.lane & 15, F.lane >> 4, F.lds, F.wave, F.lane);
                }
            } else
            if (PH_ON(2)) pg8::gemm_phase<pg8::EpiResid, false, true>(F.lds, g, S, E, F.tid, pref ? HB : nullptr);
        }
        else if (kind == 3) {
            pg8::Gemm g{HB, (const bf16_t*)(args.ws + WS_WF1) + (size_t)layer * 2 * DFF * D, D, D, 0}; pg8::StaticOrder S; S.init(M, 2 * DFF, F.G, F.bx);
            fill_rinv_tables(F, S);
            pg8::EpiSwiglu E{(bf16_t*)(args.ws + WS_HID), (const LAS float*)(F.lds + RINVL_OFF)};
            if (PH_ON(3)) pg8::gemm_phase<pg8::EpiSwiglu, true, true>(F.lds, g, S, E, F.tid);
        }
        else if (kind == 5) {
            const bool gates_late = ((F.bx >> 3) & 1) != 0;
            if (!gates_late) gates_part(F, jl);
            pg8::Gemm g{HB, (const bf16_t*)(args.ws + WS_WIN) + (size_t)jl * INW_MAIN * D, D, D, 0}; pg8::StaticOrder S; S.init(M, INW_MAIN, F.G, F.bx);
            fill_rinv_tables(F, S);
            pg8::EpiInProj E{(bf16_t*)F.H, (bf16_t*)(args.ws + WS_KT), (bf16_t*)(args.ws + WS_VT), (const LAS float*)(F.lds + RINVL_OFF), F.lds + XPOSE_OFF + F.wave * 2304};
            if (PH_ON(5)) pg8::gemm_phase<pg8::EpiInProj, true, true>(F.lds, g, S, E, F.tid);
            if (gates_late) { __syncthreads(); gates_part(F, jl); }
        }
        else if (kind == 6) { if (PH_ON(6)) scan1_phase(F, (unsigned*)(args.ws + WS_CTL) + CW_STREAM + jl * 512); }
        else if (kind == 9) { if (PH_ON(6)) scan2_phase(F, (unsigned*)(args.ws + WS_CTL) + CW_STREAM + jl * 512, (unsigned*)(args.ws + WS_CTL) + CW_STREAM + jl * 512 + 256); }
        else { if (PH_ON(7)) out_phase(F, (unsigned*)(args.ws + WS_CTL) + CW_STREAM + jl * 512 + 256); }
        { int cst = -1, cw = 0, cn = 1;
          if (kind == 0) { cst = 0; cw = F.vcu * NWAVES + F.wave; cn = F.G * NWAVES; }
          else if (kind == 3 && layer < 3 && F.bx >= 128) { cst = 1 + layer; cw = (F.bx - 128) * NWAVES + F.wave; cn = (F.G - 128) * NWAVES; }
          if (cst >= 0 && PH_ON(0)) p0_run_items(F, cst, cw, cn); }
        if (rep < ((kind == PROBE_KIND || (PROBE_KIND == 12 && kind == 2 && (layer & 1)) || (PROBE_KIND == 13 && kind == 2 && !(layer & 1))) ? PROBE_REP : 0)) { ++rep; __syncthreads(); continue; }
        rep = 0; ++ph;
        if (ph < hi) {
            const int seam = (kind == 2) ? 0 : (kind == 3) ? 1 : (kind == 7) ? 3 : (kind == 4 && (layer & 1) == 0) ? 2 : -1;
            if (kind == 6 || kind == 9) {   }
            else if (seam >= 0) team_barrier(F, (unsigned*)(args.ws + WS_CTL) + CW_TEAM + ((F.bx & 7) * 8 + ((F.bx >> 3) & 7)) * 16 + layer * 4 + seam);
            else xcd_barrier(bar, F.tid == 0);
        }
    }
}

extern "C" void kernel_launch(void* const* d_in, const int* in_sizes, int n_in, void* d_out, int out_size, void* d_ws, size_t ws_size, hipStream_t stream) {
    static int grid = 0;
    if (grid == 0) {
        if (n_in != 13 || in_sizes[0] != M * D || out_size != M * D || ws_size < WS_END) { fprintf(stderr, "kernel_launch: unexpected shapes (n_in %d, in0 %d, out %d, ws %zu)\n", n_in, n_in > 0 ? in_sizes[0] : -1, out_size, ws_size); grid = -1; return; }
        int dev = 0, cus = 0, per_cu = 0;
        if (hipGetDevice(&dev) != hipSuccess || hipDeviceGetAttribute(&cus, hipDeviceAttributeMultiprocessorCount, dev) != hipSuccess) { grid = -1; return; }
        if (hipFuncSetAttribute((const void*)mk_fwd, hipFuncAttributeMaxDynamicSharedMemorySize, LDS_BYTES) != hipSuccess) { fprintf(stderr, "kernel_launch: hipFuncSetAttribute failed\n"); grid = -1; return; }
        if (hipOccupancyMaxActiveBlocksPerMultiprocessor(&per_cu, (const void*)mk_fwd, NTHREADS, LDS_BYTES) != hipSuccess || per_cu < 1)
            fprintf(stderr, "kernel_launch: note: occupancy query reports %d workgroups per CU\n", per_cu);
        (void)hipGetLastError();
        if (cus != 256) fprintf(stderr, "kernel_launch: note: %d CUs reported; this kernel is laid out for 256 (one workgroup per CU)\n", cus);
        grid = 256;
    }
    if (grid < 0) return;
    if (hipMemsetAsync((char*)d_ws + WS_CTL, 0, CTL_ZERO_BYTES, stream) != hipSuccess) return;
    Args a{};
    for (int i = 0; i < 13; ++i) a.in[i] = (const float*)d_in[i];
    a.out = (float*)d_out; a.ws = (unsigned char*)d_ws;
#if MK_N_LAUNCHES == 1
    a.ph_lo = 0; a.ph_hi = NPHASES;
    hipLaunchKernelGGL(mk_fwd, dim3(grid), dim3(NTHREADS), LDS_BYTES, stream, a);
#else
    for (int p = 0; p < NPHASES; ++p) { a.ph_lo = p; a.ph_hi = p + 1; hipLaunchKernelGGL(mk_fwd, dim3(grid), dim3(NTHREADS), LDS_BYTES, stream, a); }
#endif
}
```

```cpp
#include <hip/hip_runtime.h>
#include <cstdio>
#include <cstdint>

#ifndef MK_N_LAUNCHES
#define MK_N_LAUNCHES 1
#endif
#ifndef PH_MASK
#define PH_MASK 0x1ff
#endif
#define PH_ON(k) ((PH_MASK >> (k)) & 1)
#ifndef PROBE_KIND
#define PROBE_KIND -1
#endif
#ifndef PROBE_REP
#define PROBE_REP 0
#endif

#define LAS __attribute__((address_space(3)))
#define GAS __attribute__((address_space(1)))
typedef unsigned short bf16_t;
typedef short bf16x8 __attribute__((ext_vector_type(8)));
typedef float f32x4 __attribute__((ext_vector_type(4)));
typedef float f32x2 __attribute__((ext_vector_type(2)));
typedef unsigned u32x4 __attribute__((ext_vector_type(4)));
typedef unsigned u32x2 __attribute__((ext_vector_type(2)));
typedef GAS unsigned gu32;

constexpr int D = 1024, BATCH = 4, SEQ = 4096, M = BATCH * SEQ, DEPTH = 4;
constexpr int NH = 4, DV = 256, DQK = 128, INW = 3080, INW_MAIN = 3072;
constexpr int DFF = 2816;
constexpr int LC = 256, NCH = SEQ / LC, NSTREAM = BATCH * NH;
constexpr float EPS = 1e-6f;
constexpr int NWAVES = 8, NTHREADS = 512;
constexpr int NPHASES = 21;

constexpr size_t MiB = 1u << 20;
constexpr size_t WS_CTL = 0, CTL_ZERO_BYTES = 64 * 1024;
constexpr size_t WS_WPOOL = 1 * MiB;
constexpr size_t WS_WG = 2 * MiB;
constexpr size_t WS_WGB = WS_WG + 128 * 1024;
constexpr size_t WS_WIN = 3 * MiB;
constexpr size_t WS_WOUT = 15 * MiB;
constexpr size_t WS_WF1 = 19 * MiB;
constexpr size_t WS_WF2 = 63 * MiB;
constexpr size_t WS_HB = 85 * MiB;
constexpr size_t WS_SSQ = 117 * MiB;
constexpr size_t WS_GI = 118 * MiB;
constexpr size_t WS_GF = WS_GI + 256 * 1024;
constexpr size_t WS_TA = WS_GF + 256 * 1024;
constexpr size_t WS_TM = WS_TA + 256 * 1024;
constexpr size_t WS_TB = WS_TM + 256 * 1024;
constexpr size_t WS_MPREV = WS_TB + 256 * 1024;
constexpr size_t WS_DEC = WS_MPREV + 2048;
constexpr size_t WS_NST = WS_MPREV + 4096;
constexpr size_t WS_LOCN = WS_NST + 131072;
constexpr size_t WS_R = 120 * MiB;
constexpr size_t WS_HID = WS_R;
constexpr size_t WS_KT = WS_R + 88 * MiB;
constexpr size_t WS_VT = WS_R + 104 * MiB;
constexpr size_t WS_HG = WS_R + 136 * MiB;
constexpr size_t WS_LOC = WS_R + 217 * MiB;
constexpr size_t WS_CST = WS_R + 168 * MiB;
constexpr size_t WS_HB2 = WS_R + 184 * MiB;
constexpr size_t WS_SSQ2 = WS_R + 216 * MiB;
constexpr size_t WS_END = WS_R + 232 * MiB;
static_assert(WS_HID + (size_t)M * DFF * 2 <= WS_KT && WS_LOCN + 16 * 15 * 128 * 4 <= WS_R && WS_LOC + (size_t)16 * 15 * 256 * 128 * 2 <= WS_END && WS_HG + (size_t)M * D * 2 <= WS_CST && WS_WF2 + (size_t)4 * 1024 * 2816 * 2 <= WS_HB, "d_ws map");
constexpr int CW_BAR = 1024;
constexpr int CW_TEAM = 12288;
constexpr int CW_STREAM = 13312;
constexpr int CW_PANEL = 8192;
static_assert((CW_PANEL + 64 * 64) * 4 <= (int)CTL_ZERO_BYTES, "panel counters inside the memset region");

constexpr int RING_BYTES = 131072;
constexpr int XPOSE_OFF = RING_BYTES, XPOSE_BYTES = 8 * 2304;
constexpr int RINVL_OFF = XPOSE_OFF + XPOSE_BYTES, RINVL_BYTES = 8 * 1024;
constexpr int PA_LG = 272, PA_BLK = 4 * PA_LG, PA_BYTES = 128 * PA_BLK, PA_RINV_OFF = PA_BYTES;
constexpr int BASE8_OFF = XPOSE_OFF + 8 * 1024;
constexpr int LDSCTL_OFF = 160 * 1024 - 1024, MISC_OFF = LDSCTL_OFF + 320;
static_assert(BASE8_OFF + 16384 <= LDSCTL_OFF, "LDS map (base piece)");
static_assert(PA_RINV_OFF + 272 * 4 <= XPOSE_OFF + 5 * 1024 + 8 * 1024 && PA_RINV_OFF + 272 * 4 <= LDSCTL_OFF, "pool phase LDS map");
static_assert(8 * 16640 <= LDSCTL_OFF && RINVL_OFF + RINVL_BYTES <= LDSCTL_OFF, "LDS map");
constexpr int LDS_BYTES = 163840;

#define RLX_AGENT __ATOMIC_RELAXED, __HIP_MEMORY_SCOPE_AGENT
#define LDS_WAIT() asm volatile("s_waitcnt lgkmcnt(0)" ::: "memory")
#define VM_WAIT() asm volatile("s_waitcnt vmcnt(0)" ::: "memory")

typedef __bf16 bf16v2 __attribute__((ext_vector_type(2)));
__device__ __forceinline__ unsigned cvt_pk_bf16(float lo, float hi) { const bf16v2 r = __builtin_convertvector((f32x2){lo, hi}, bf16v2); return __builtin_bit_cast(unsigned, r); }
__device__ __forceinline__ void st16_wt(void* base, unsigned byte_off, u32x4 v) {
    __builtin_amdgcn_raw_buffer_store_b128(v, __builtin_amdgcn_make_buffer_rsrc(base, 0, 0x7fffffff, 0x00020000), byte_off, 0, 16);
}
__device__ __forceinline__ float bf2f(unsigned short b) { return __uint_as_float(((unsigned)b) << 16); }
__device__ __forceinline__ float bflo(unsigned u) { return __uint_as_float(u << 16); }
__device__ __forceinline__ float bfhi(unsigned u) { return __uint_as_float(u & 0xffff0000u); }
__device__ __forceinline__ float lane_get(float v, int src) { return __builtin_bit_cast(float, __builtin_amdgcn_ds_bpermute(src << 2, __builtin_bit_cast(int, v))); }
__device__ __forceinline__ float lane_xor(float v, int mask, int lane) { return lane_get(v, lane ^ mask); }
__device__ __forceinline__ float wave_sum(float v, int lane) {
#pragma unroll
    for (int o = 1; o < 64; o <<= 1) v += lane_xor(v, o, lane);
    return v;
}
__device__ __forceinline__ float rinv_of(const f32x4 s) { return __builtin_amdgcn_rsqf(((s.x + s.y) + (s.z + s.w)) * (1.0f / D) + EPS); }

namespace pg8 {
constexpr int BM = 256, BK = 64, HALF = 128, HTB = HALF * BK * 2, STAGE_BYTES = 8 * HTB, NXCD = 8, WGM = 8;
__host__ __device__ __forceinline__ int lds_byte(int r, int c) { const int st = (r >> 4) * 2 + (c >> 5), rr = r & 15, cc = c & 31, ob = rr * 64 + cc * 2; return st * 1024 + (ob ^ (((ob >> 9) & 1) << 5)); }
__host__ __device__ __forceinline__ void stage_rc(int b, int& R, int& C) { const int st = b / 1024, sb = b % 1024, swz = sb ^ (((sb >> 9) & 1) << 5); R = (st >> 1) * 16 + swz / 64; C = (st & 1) * 32 + (swz % 64) / 2; }
__host__ __device__ __forceinline__ int perm32(int rho) { const int n = rho >> 4, i = rho & 15; return 8 * (i >> 2) + 4 * n + (i & 3); }

struct Unit { int pm, pn; };
struct Gemm { const bf16_t* A; const bf16_t* Bt; int lda, K, grouped; };

struct StaticOrder {
    int nM, nN, nwg, G, c;
    __device__ __forceinline__ void init(int M_, int N_, int G_, int c_) { nM = M_ / BM; nN = N_ / BM; nwg = nM * nN; G = G_; c = c_; }
    __device__ __forceinline__ bool next(int i, Unit& u) const {
        const long L = (long)i * G + c; if (L >= nwg) return false;
        int wgid = (int)L; { const int q = nwg / NXCD, r = nwg % NXCD, xcd = wgid % NXCD, off = wgid / NXCD; wgid = (xcd < r ? xcd * (q + 1) : r * (q + 1) + (xcd - r) * q) + off; }
        const int nig = WGM * nN, gid = wgid / nig, fm = gid * WGM, gsz = (nM - fm) < WGM ? (nM - fm) : WGM;
        u.pm = fm + ((wgid % nig) % gsz); u.pn = (wgid % nig) / gsz; return true;
    }
};


struct EpiSwiglu {
    static constexpr bool PERM = true, AFTER_DRAIN = false, SWAPS = false;
    bf16_t* O; const LAS float* rl;
    __device__ __forceinline__ void operator()(const f32x4 (&acc)[2][2][4][2], const Unit& u, int ui, int wr, int wc, int fr, int fq) const {
        const int row0 = u.pm * BM + wr * 64 + fr, col0 = u.pn * 128 + wc * 32 + 8 * fq;
#pragma unroll
        for (int ai = 0; ai < 2; ++ai)
#pragma unroll
            for (int m = 0; m < 4; ++m) {
                const int row = row0 + ai * HALF + m * 16;
                const float ri = rl[ui * 256 + wr * 64 + fr + ai * HALF + m * 16];
                float h[8];
#pragma unroll
                for (int n = 0; n < 2; ++n)
#pragma unroll
                    for (int j = 0; j < 4; ++j) {
                        const float g = acc[ai][0][m][n][j] * ri, up = acc[ai][1][m][n][j] * ri;
                        h[n * 4 + j] = g * __builtin_amdgcn_rcpf(1.0f + __expf(-g)) * up;
                    }
                u32x4 w; w.x = cvt_pk_bf16(h[0], h[1]); w.y = cvt_pk_bf16(h[2], h[3]); w.z = cvt_pk_bf16(h[4], h[5]); w.w = cvt_pk_bf16(h[6], h[7]);
                st16_wt(O, (unsigned)((row * DFF + col0) * 2), w);
            }
    }
};
struct EpiInProj {
    static constexpr bool PERM = true, AFTER_DRAIN = false, SWAPS = true;
    bf16_t* QKO; bf16_t* KT; bf16_t* VT; const LAS float* rl; LAS unsigned char* xb;
    __device__ __forceinline__ bool swapped(const Unit& u) const { return u.pn >= 4 && u.pn < 8; }
    __device__ __forceinline__ void operator()(f32x4 (&acc)[2][2][4][2], const Unit& u, int ui, int wr, int wc, int fr_, int fq_) const {
        int fr = fr_, fq = fq_; asm volatile("" : "+v"(fr), "+v"(fq));
        const int row0 = u.pm * BM + wr * 64 + fr;
        const int pn = u.pn;
        const bool is_v = (pn >= 4 && pn < 8);
        const int bb = (u.pm * BM) / SEQ;
        if (is_v) {
            asm volatile("" ::: "memory");
            const __amdgpu_buffer_rsrc_t rV = __builtin_amdgcn_make_buffer_rsrc(VT, 0, 0x7fffffff, 0x00020000);
            const unsigned vo = (unsigned)((fr * SEQ + wc * 32 + 8 * fq) * 2);
            const unsigned so = (unsigned)((((bb * NH + (pn - 4)) * DV + wr * 64) * SEQ + (u.pm * BM) % SEQ) * 2);
#pragma unroll
            for (int bj = 0; bj < 2; ++bj) {
                const f32x4 rv0 = *(const LAS f32x4*)(rl + ui * 256 + bj * HALF + wc * 32 + 8 * fq), rv1 = *(const LAS f32x4*)(rl + ui * 256 + bj * HALF + wc * 32 + 8 * fq + 4);
#pragma unroll
                for (int ai = 0; ai < 2; ++ai)
#pragma unroll
                    for (int m = 0; m < 4; ++m) {
                        const f32x4 v0 = acc[ai][bj][m][0] * rv0, v1 = acc[ai][bj][m][1] * rv1;
                        u32x4 w; w.x = cvt_pk_bf16(v0[0], v0[1]); w.y = cvt_pk_bf16(v0[2], v0[3]); w.z = cvt_pk_bf16(v1[0], v1[1]); w.w = cvt_pk_bf16(v1[2], v1[3]);
                        __builtin_amdgcn_raw_buffer_store_b128(w, rV, vo, so + (unsigned)(((ai * HALF + m * 16) * SEQ + bj * HALF) * 2), 0); }
                __builtin_amdgcn_sched_barrier(0);
            }
            return;
        }
        asm volatile("" ::: "memory");
        const int ncol0 = (pn < 4 ? pn * 256 : (pn - 4) * 256) + wc * 32 + 8 * fq;
#pragma unroll
        for (int ai = 0; ai < 2; ++ai)
#pragma unroll
            for (int m = 0; m < 4; ++m) { const int row = row0 + ai * HALF + m * 16; const float ri = rl[ui * 256 + wr * 64 + fr + ai * HALF + m * 16];
#pragma unroll
                for (int bj = 0; bj < 2; ++bj) { const f32x4 v0 = acc[ai][bj][m][0] * ri, v1 = acc[ai][bj][m][1] * ri;
                    u32x4 w; w.x = cvt_pk_bf16(v0[0], v0[1]); w.y = cvt_pk_bf16(v0[2], v0[3]); w.z = cvt_pk_bf16(v1[0], v1[1]); w.w = cvt_pk_bf16(v1[2], v1[3]);
                    *(u32x4*)(QKO + (size_t)row * 2048 + ncol0 + bj * HALF) = w; } }
    }
};
struct EpiResid {
    static constexpr bool PERM = true, AFTER_DRAIN = true, SWAPS = false;
    const float* basef; const bf16_t* hbr; bf16_t* hb; float* ssq;
    bool lds_base;
    const float* fgain; float* fout; unsigned* pcnt;
    __device__ __forceinline__ void fused(f32x4 (&acc)[2][2][4][2], const Unit& u, int wr, int wc, int fr, int fq, LAS unsigned char* lds, int wid, int lane) const {
        LAS float* P = (LAS float*)(lds + XPOSE_OFF);
        LAS float* R = P + 1024;
        const int col0 = u.pn * BM + wc * 32 + 8 * fq;
        const bool fin = (fgain != nullptr);
#pragma unroll
        for (int ai = 0; ai < 2; ++ai) {
            const size_t off0 = (size_t)(u.pm * BM + ai * HALF + wr * 64 + fr) * D + col0;
            if (basef) {
#pragma unroll
                for (int m = 0; m < 4; ++m)
#pragma unroll
                    for (int bj = 0; bj < 2; ++bj) { const float* bp = basef + off0 + (size_t)m * 16 * D + bj * HALF;
                        acc[ai][bj][m][0] += *(const f32x4*)bp; acc[ai][bj][m][1] += *(const f32x4*)(bp + 4); }
            } else {
                u32x4 hv[4][2];
#pragma unroll
                for (int m = 0; m < 4; ++m)
#pragma unroll
                    for (int bj = 0; bj < 2; ++bj) {
                        const int ch = 2 * bj + (wc >> 1);
                        if (lds_base) {
                            const int so = (ch == 3 && ai == 1) ? BASE8_OFF : ((ch == 0) ? ai : (ch == 1) ? 4 + ai : (ch == 2) ? 6 + ai : 2) * HTB;
                            hv[m][bj] = *(const LAS u32x4*)(lds + so + lds_byte(wr * 64 + m * 16 + fr, (wc & 1) * 32 + 8 * fq));
                        } else hv[m][bj] = *(const u32x4*)(hbr + off0 + (size_t)m * 16 * D + bj * HALF); }
#pragma unroll
                for (int m = 0; m < 4; ++m)
#pragma unroll
                    for (int bj = 0; bj < 2; ++bj) { const u32x4 h = hv[m][bj];
                        acc[ai][bj][m][0] += (f32x4){bflo(h.x), bfhi(h.x), bflo(h.y), bfhi(h.y)}; acc[ai][bj][m][1] += (f32x4){bflo(h.z), bfhi(h.z), bflo(h.w), bfhi(h.w)}; }
            }
#pragma unroll
            for (int m = 0; m < 4; ++m) { const int r = ai * HALF + wr * 64 + m * 16 + fr; float ss = 0.f;
#pragma unroll
                for (int bj = 0; bj < 2; ++bj) { const f32x4 o0 = acc[ai][bj][m][0], o1 = acc[ai][bj][m][1];
                    if (!fin) { u32x4 w; w.x = cvt_pk_bf16(o0[0], o0[1]); w.y = cvt_pk_bf16(o0[2], o0[3]); w.z = cvt_pk_bf16(o1[0], o1[1]); w.w = cvt_pk_bf16(o1[2], o1[3]);
                        st16_wt(hb, (unsigned)((off0 + (size_t)m * 16 * D + bj * HALF) * 2), w); }
                    ss += ((o0[0] * o0[0] + o0[1] * o0[1]) + (o0[2] * o0[2] + o0[3] * o0[3])) + ((o1[0] * o1[0] + o1[1] * o1[1]) + (o1[2] * o1[2] + o1[3] * o1[3])); }
                ss += lane_xor(ss, 16, lane); ss += lane_xor(ss, 32, lane);
                if (fq == 0) P[r * 4 + wc] = ss; }
            asm volatile("" ::: "memory");
        }
        asm volatile("s_waitcnt lgkmcnt(0)" ::: "memory"); __builtin_amdgcn_s_barrier(); asm volatile("" ::: "memory");
        const int tid = wid * 64 + lane;
        if (!fin) {
            if (tid < 256) { const f32x4 p = *(LAS f32x4*)(P + tid * 4); __hip_atomic_store((unsigned*)(ssq + (size_t)(u.pm * BM + tid) * 4 + u.pn), __float_as_uint((p.x + p.y) + (p.z + p.w)), __ATOMIC_RELAXED, __HIP_MEMORY_SCOPE_AGENT); }
            return;
        }
        float* slot = ssq + (size_t)(u.pm * BM) * 4;
        if (tid < 256) { const f32x4 p = *(LAS f32x4*)(P + tid * 4); __hip_atomic_store((unsigned*)(slot + tid * 4 + u.pn), __float_as_uint((p.x + p.y) + (p.z + p.w)), __ATOMIC_RELAXED, __HIP_MEMORY_SCOPE_AGENT); }
        asm volatile("s_waitcnt vmcnt(0)" ::: "memory");
        __builtin_amdgcn_s_barrier(); asm volatile("" ::: "memory");
        if (tid == 0) {
            unsigned* c = pcnt + 64 * u.pm;
            __hip_atomic_fetch_add(c, 1u, __ATOMIC_RELAXED, __HIP_MEMORY_SCOPE_AGENT);
            unsigned spins = 0;
            while (__hip_atomic_load(c, __ATOMIC_RELAXED, __HIP_MEMORY_SCOPE_AGENT) < 4u) { __builtin_amdgcn_s_sleep(2); if (++spins > (1u << 20)) break; }
            __builtin_amdgcn_fence(__ATOMIC_ACQUIRE, "agent");
            asm volatile("s_waitcnt vmcnt(0)" ::: "memory");
        }
        __builtin_amdgcn_s_barrier(); asm volatile("" ::: "memory");
        if (tid < 256) {
            const u32x4 pv = __builtin_amdgcn_raw_buffer_load_b128(__builtin_amdgcn_make_buffer_rsrc((void*)slot, 0, 0x7fffffff, 0x00020000), (unsigned)(tid * 16), 0u, 16);
            const float t4 = (__uint_as_float(pv.x) + __uint_as_float(pv.y)) + (__uint_as_float(pv.z) + __uint_as_float(pv.w));
            R[tid] = __builtin_amdgcn_rsqf(t4 * (1.0f / D) + EPS); }
        asm volatile("s_waitcnt lgkmcnt(0)" ::: "memory"); __builtin_amdgcn_s_barrier(); asm volatile("" ::: "memory");
#pragma unroll
        for (int bj = 0; bj < 2; ++bj) {
            const f32x4 g0 = *(const f32x4*)(fgain + col0 + bj * HALF), g1 = *(const f32x4*)(fgain + col0 + bj * HALF + 4);
#pragma unroll
            for (int ai = 0; ai < 2; ++ai)
#pragma unroll
                for (int m = 0; m < 4; ++m) { const int r = ai * HALF + wr * 64 + m * 16 + fr; const float ri = R[r];
                    float* op = fout + (size_t)(u.pm * BM + r) * D + col0 + bj * HALF;
                    *(f32x4*)op = acc[ai][bj][m][0] * ri * g0; *(f32x4*)(op + 4) = acc[ai][bj][m][1] * ri * g1; }
        }
    }
};

template <class Epi, bool ALIGN_EPI, bool SP2>
__device__ __forceinline__ void gemm_phase(LAS unsigned char* lds, const Gemm g, const StaticOrder& S, const Epi& E, const int tid, const bf16_t* tail = nullptr) {
    const int wid = __builtin_amdgcn_readfirstlane(tid >> 6), lane = tid & 63, wr = wid >> 2, wc = wid & 3, fr = lane & 15, fq = lane >> 4;
    const int K = g.K, nt = K / BK, lda = g.lda;
    unsigned voffA[2], voffB[2];
#pragma unroll
    for (int i = 0; i < 2; ++i) { int R, C; stage_rc(tid * 16 + i * 8192, R, C); const int Rb = Epi::PERM ? ((R & ~31) + perm32(R & 31)) : R;
        voffA[i] = (unsigned)(R * lda + C) * 2u; voffB[i] = (unsigned)(Rb * K + C) * 2u; }
    const size_t kstep = (size_t)(BK * 2);
    const size_t hstepA = (size_t)HALF * lda * 2, hstepB = (size_t)HALF * K * 2;
    const size_t tstepA = 2 * hstepA, tstepB = 2 * hstepB;
    const size_t gstep = g.grouped ? (size_t)K * 2 : 0;
    const unsigned ldsw = (unsigned)wid * 1024u;
    const int aoff = lds_byte(wr * 64 + fr, fq * 8), boff = lds_byte(wc * 32 + fr, fq * 8);
#define PG8_SA(b, h) (((b) * 2 + (h)) * HTB)
#define PG8_SB(b, h) ((4 + (b) * 2 + (h)) * HTB)
#define PG8_STAGE(bufoff, gbase, voff) do { _Pragma("unroll") for (int _i = 0; _i < 2; ++_i) \
        __builtin_amdgcn_global_load_lds((const unsigned*)((const char*)(gbase) + (voff)[_i]), (LAS unsigned*)(lds + (bufoff) + ldsw + _i * 8192), 16, 0, 0); } while (0)
#define PG8_LDA(dst, b, h) do { _Pragma("unroll") for (int m = 0; m < 4; ++m) _Pragma("unroll") for (int k = 0; k < 2; ++k) dst[m][k] = *(const LAS bf16x8*)(lds + PG8_SA(b, h) + aoff + m * 2048 + k * 1024); } while (0)
#define PG8_LDB(dst, b, h) do { _Pragma("unroll") for (int n = 0; n < 2; ++n) _Pragma("unroll") for (int k = 0; k < 2; ++k) dst[n][k] = *(const LAS bf16x8*)(lds + PG8_SB(b, h) + boff + n * 2048 + k * 1024); } while (0)
#define PG8_MMA(ai, bj, At, Bt) do { __builtin_amdgcn_s_setprio(1); _Pragma("unroll") for (int m = 0; m < 4; ++m) _Pragma("unroll") for (int n = 0; n < 2; ++n) _Pragma("unroll") for (int k = 0; k < 2; ++k) \
        acc[ai][bj][m][n] = __builtin_amdgcn_mfma_f32_16x16x32_bf16(Bt[n][k], At[m][k], acc[ai][bj][m][n], 0, 0, 0); __builtin_amdgcn_s_setprio(0); } while (0)
#define PG8_WAIT_V(n) asm volatile("s_waitcnt vmcnt(" #n ")" ::: "memory")
#define PG8_WAIT_L(n) asm volatile("s_waitcnt lgkmcnt(" #n ")" ::: "memory")
#define PG8_BAR __builtin_amdgcn_s_barrier()
#define PG8_SCHED __builtin_amdgcn_sched_barrier(0)
    Unit cur, nxt; int ui = 0;
    if (!S.next(0, cur)) return;
    f32x4 acc[2][2][4][2];
#pragma unroll
    for (int a = 0; a < 2; ++a)
#pragma unroll
        for (int b = 0; b < 2; ++b)
#pragma unroll
            for (int m = 0; m < 4; ++m)
#pragma unroll
                for (int n = 0; n < 2; ++n) acc[a][b][m][n] = (f32x4){0.f, 0.f, 0.f, 0.f};
    bf16x8 At[4][2], B0[2][2], B1[2][2];
    const char* cA = (const char*)g.A + (size_t)cur.pm * tstepA + (size_t)cur.pn * gstep; const char* cB = (const char*)g.Bt + (size_t)cur.pn * tstepB;
    if constexpr (Epi::SWAPS) { if (E.swapped(cur)) { const char* t_ = cA; cA = cB; cB = t_; } }
    if constexpr (SP2) {
        if constexpr (Epi::AFTER_DRAIN) { if (tail != nullptr) {
            unsigned vh[2];
#pragma unroll
            for (int i = 0; i < 2; ++i) { int R, C; stage_rc(tid * 16 + i * 8192, R, C); vh[i] = (unsigned)(R * D + C) * 2u; }
            const char* p31 = (const char*)tail + ((size_t)cur.pm * BM * D + (size_t)cur.pn * BM + (size_t)HALF * D + 3 * 64) * 2;
            PG8_STAGE(BASE8_OFF, p31, vh); } }
        PG8_STAGE(PG8_SB(0, 0), cB, voffB); PG8_STAGE(PG8_SB(0, 1), cB + hstepB, voffB); PG8_STAGE(PG8_SA(0, 0), cA, voffA); PG8_STAGE(PG8_SA(0, 1), cA + hstepA, voffA);
        if (wr == 1) PG8_BAR;
        PG8_WAIT_V(2); PG8_BAR;
        PG8_STAGE(PG8_SB(1, 0), cB + kstep, voffB); PG8_STAGE(PG8_SA(1, 0), cA + kstep, voffA); PG8_STAGE(PG8_SB(1, 1), cB + hstepB + kstep, voffB);
        PG8_WAIT_V(6); PG8_BAR;
    } else {
        PG8_STAGE(PG8_SB(0, 0), cB, voffB); PG8_STAGE(PG8_SA(0, 0), cA, voffA); PG8_STAGE(PG8_SB(0, 1), cB + hstepB, voffB); PG8_STAGE(PG8_SA(0, 1), cA + hstepA, voffA);
        if (wr == 1) PG8_BAR;
        PG8_WAIT_V(4); PG8_BAR;
        PG8_STAGE(PG8_SB(1, 0), cB + kstep, voffB); PG8_STAGE(PG8_SA(1, 0), cA + kstep, voffA); PG8_STAGE(PG8_SB(1, 1), cB + hstepB + kstep, voffB);
        PG8_WAIT_V(6); PG8_BAR;
    }
    for (;;) {
        const bool has_next = S.next(ui + 1, nxt);
        const char* nA = has_next ? (const char*)g.A + (size_t)nxt.pm * tstepA + (size_t)nxt.pn * gstep : cA; const char* nB = has_next ? (const char*)g.Bt + (size_t)nxt.pn * tstepB : cB;
        if constexpr (Epi::SWAPS) { if (has_next && E.swapped(nxt)) { const char* t_ = nA; nA = nB; nB = t_; } }
        for (int t = 0; t < nt; t += 2) {
            const bool last = (t == nt - 2);
            const char* a1 = cA + (size_t)(t + 1) * kstep;
            const char* a2 = last ? nA : cA + (size_t)(t + 2) * kstep; const char* b2 = last ? nB : cB + (size_t)(t + 2) * kstep;
            const char* a3 = a2 + kstep; const char* b3 = b2 + kstep;
            if constexpr (SP2) {
            const bool tl = Epi::AFTER_DRAIN && last && !has_next && tail != nullptr;
            const char* tp = (const char*)tail + ((size_t)cur.pm * BM * D + (size_t)cur.pn * BM) * 2;
#define PG8_PIECE(ch, rh) (tp + ((size_t)(rh) * HALF * D + (ch) * 64) * 2)
#define PG8_VOFFH unsigned voffH[2]; { unsigned o_ = ~0u; asm volatile("" : "+s"(o_)); const int tid_ = wid * 64 + (int)__builtin_amdgcn_mbcnt_hi(o_, __builtin_amdgcn_mbcnt_lo(o_, 0u));   \
        _Pragma("unroll") for (int i_ = 0; i_ < 2; ++i_) { int R_, C_; stage_rc(tid_ * 16 + i_ * 8192, R_, C_); voffH[i_] = (unsigned)(R_ * D + C_) * 2u; } }
            PG8_LDB(B0, 0, 0); PG8_LDB(B1, 0, 1); PG8_SCHED; PG8_LDA(At, 0, 0); PG8_STAGE(PG8_SA(1, 1), a1 + hstepA, voffA);
            PG8_WAIT_V(8); PG8_WAIT_L(0); PG8_BAR; PG8_MMA(0, 0, At, B0); PG8_MMA(0, 1, At, B1); PG8_BAR; PG8_SCHED;
            PG8_LDA(At, 0, 1);
            if (tl) { PG8_VOFFH; PG8_STAGE(PG8_SB(0, 0), PG8_PIECE(1, 0), voffH); PG8_STAGE(PG8_SB(0, 1), PG8_PIECE(1, 1), voffH); PG8_STAGE(PG8_SA(0, 0), PG8_PIECE(0, 0), voffH); }
            else    { PG8_STAGE(PG8_SB(0, 0), b2, voffB); PG8_STAGE(PG8_SB(0, 1), b2 + hstepB, voffB); PG8_STAGE(PG8_SA(0, 0), a2, voffA); }
            PG8_WAIT_V(8); PG8_WAIT_L(0); PG8_BAR; PG8_MMA(1, 0, At, B0); PG8_MMA(1, 1, At, B1); PG8_BAR; PG8_SCHED;
            PG8_LDB(B0, 1, 0); PG8_LDB(B1, 1, 1); PG8_SCHED; PG8_LDA(At, 1, 0);
            if (tl) { PG8_VOFFH; PG8_STAGE(PG8_SA(0, 1), PG8_PIECE(0, 1), voffH); } else { PG8_STAGE(PG8_SA(0, 1), a2 + hstepA, voffA); }
            PG8_WAIT_V(8); PG8_WAIT_L(0); PG8_BAR; PG8_MMA(0, 0, At, B0); PG8_MMA(0, 1, At, B1); PG8_BAR; PG8_SCHED;
            PG8_LDA(At, 1, 1);
            if (tl) { PG8_VOFFH; PG8_STAGE(PG8_SB(1, 0), PG8_PIECE(2, 0), voffH); PG8_STAGE(PG8_SB(1, 1), PG8_PIECE(2, 1), voffH); PG8_STAGE(PG8_SA(1, 0), PG8_PIECE(3, 0), voffH); }
            else    { PG8_STAGE(PG8_SB(1, 0), b3, voffB); PG8_STAGE(PG8_SB(1, 1), b3 + hstepB, voffB); PG8_STAGE(PG8_SA(1, 0), a3, voffA); }
            PG8_WAIT_V(8); PG8_WAIT_L(0); PG8_BAR; PG8_MMA(1, 0, At, B0); PG8_MMA(1, 1, At, B1); PG8_BAR; PG8_SCHED;
#undef PG8_PIECE
#undef PG8_VOFFH
            } else {
            PG8_LDB(B0, 0, 0); PG8_SCHED; PG8_LDA(At, 0, 0); PG8_STAGE(PG8_SA(1, 1), a1 + hstepA, voffA);
            PG8_WAIT_L(8); PG8_BAR; PG8_WAIT_L(0); PG8_MMA(0, 0, At, B0); PG8_BAR; PG8_SCHED;
            PG8_LDB(B1, 0, 1); PG8_STAGE(PG8_SB(0, 0), b2, voffB);
            PG8_BAR; PG8_WAIT_L(0); PG8_MMA(0, 1, At, B1); PG8_BAR;
            PG8_LDA(At, 0, 1); PG8_STAGE(PG8_SA(0, 0), a2, voffA);
            PG8_BAR; PG8_WAIT_L(0); PG8_MMA(1, 0, At, B0); PG8_BAR; PG8_SCHED;
            PG8_STAGE(PG8_SB(0, 1), b2 + hstepB, voffB);
            PG8_WAIT_V(6); PG8_BAR; PG8_MMA(1, 1, At, B1); PG8_BAR;
            PG8_LDB(B0, 1, 0); PG8_SCHED; PG8_LDA(At, 1, 0); PG8_STAGE(PG8_SA(0, 1), a2 + hstepA, voffA);
            PG8_WAIT_L(8); PG8_BAR; PG8_WAIT_L(0); PG8_MMA(0, 0, At, B0); PG8_BAR; PG8_SCHED;
            PG8_LDB(B1, 1, 1); PG8_STAGE(PG8_SB(1, 0), b3, voffB);
            PG8_BAR; PG8_WAIT_L(0); PG8_MMA(0, 1, At, B1); PG8_BAR;
            PG8_LDA(At, 1, 1); PG8_STAGE(PG8_SA(1, 0), a3, voffA);
            PG8_BAR; PG8_WAIT_L(0); PG8_MMA(1, 0, At, B0); PG8_BAR; PG8_SCHED;
            PG8_STAGE(PG8_SB(1, 1), b3 + hstepB, voffB);
            PG8_WAIT_V(6); PG8_BAR; PG8_MMA(1, 1, At, B1); PG8_BAR;
            }
        }
        if constexpr (ALIGN_EPI) { if (wr == 0) PG8_BAR; }
        if constexpr (!Epi::AFTER_DRAIN) { E(acc, cur, ui, wr, wc, fr, fq); }
        if (!has_next) break;
#pragma unroll
        for (int a = 0; a < 2; ++a)
#pragma unroll
            for (int b = 0; b < 2; ++b)
#pragma unroll
                for (int m = 0; m < 4; ++m)
#pragma unroll
                    for (int n = 0; n < 2; ++n) acc[a][b][m][n] = (f32x4){0.f, 0.f, 0.f, 0.f};
        cur = nxt; cA = nA; cB = nB; ++ui;
        if constexpr (ALIGN_EPI) { if (wr == 1) PG8_BAR; }
    }
    PG8_WAIT_V(0);
    if constexpr (!ALIGN_EPI) { if (wr == 0) PG8_BAR; }
    PG8_BAR;
    if constexpr (Epi::AFTER_DRAIN) { E.fused(acc, cur, wr, wc, fr, fq, lds, wid, lane); }
#undef PG8_SA
#undef PG8_SB
#undef PG8_STAGE
#undef PG8_LDA
#undef PG8_LDB
#undef PG8_MMA
#undef PG8_WAIT_V
#undef PG8_WAIT_L
#undef PG8_BAR
#undef PG8_SCHED
}
}

#define XB_TMO      128
#define XB_XCNT(j)  (256  + 64 * (j))
#define XB_XSUB(j)  (1280 + 64 * (j))
#define XB_XGEN(j)  (2304 + 64 * (j))
#define XB_TOP      3328
#define XB_TOPGEN   3392
#define XCD_BAR_WORDS 3456
#define XB_SPIN_CAP (1u << 18)
static_assert((CW_BAR + XCD_BAR_WORDS) * 4 <= (int)CTL_ZERO_BYTES, "barrier words inside the memset region");

__device__ __forceinline__ unsigned xb_ld(unsigned* p)              { return __hip_atomic_load(p, __ATOMIC_RELAXED, __HIP_MEMORY_SCOPE_AGENT); }
__device__ __forceinline__ unsigned xb_add(unsigned* p, unsigned v) { return __hip_atomic_fetch_add(p, v, __ATOMIC_RELAXED, __HIP_MEMORY_SCOPE_AGENT); }
__device__ __forceinline__ unsigned xb_xcc_id() { return (unsigned)__builtin_amdgcn_s_getreg((3 << 11) | 20) & 0xFu; }
#define XB_SPIN(cond, bar) do { unsigned _sp = 0; while (cond) { __builtin_amdgcn_s_sleep(1); \
    if ((++_sp & 255u) == 0u) { if (xb_ld(&(bar)[XB_TMO])) break; if (_sp > XB_SPIN_CAP) { atomicAdd(&(bar)[XB_TMO], 1u); break; } } } } while (0)

struct XcdBarrier { unsigned* bar; unsigned x; volatile LAS unsigned* st; };
__device__ __forceinline__ XcdBarrier xcd_barrier_post(unsigned* bar, volatile LAS unsigned* st) {
    XcdBarrier b; b.bar = bar; b.x = xb_xcc_id(); b.st = st;
    if (threadIdx.x == 0) (void)xb_add(&bar[XB_XCNT(b.x)], 1u);
    return b;
}
__device__ __forceinline__ void xcd_barrier_complete(unsigned* bar, unsigned x, unsigned& nloc, unsigned& nx) {
    const unsigned G = gridDim.x * gridDim.y * gridDim.z;
    unsigned sum, cnt, mine, sp = 0u;
    for (;;) {
        sum = 0u; cnt = 0u; mine = 0u;
        unsigned cv[16];
        { const __amdgpu_buffer_rsrc_t rb = __builtin_amdgcn_make_buffer_rsrc((void*)bar, 0, 0x7fffffff, 0x00020000);
#pragma unroll
          for (unsigned j = 0; j < 16; ++j) cv[j] = __builtin_amdgcn_raw_buffer_load_b32(rb, 0u, (unsigned)(XB_XCNT(j) * 4), 16); }
#pragma unroll
        for (unsigned j = 0; j < 16; ++j) { const unsigned c = cv[j]; sum += c; cnt += (c > 0u) ? 1u : 0u; mine = (j == x) ? c : mine; }
        if (sum == G) break;
        __builtin_amdgcn_s_sleep(1);
        if ((++sp & 255u) == 0u) { if (xb_ld(&bar[XB_TMO])) break; if (sp > XB_SPIN_CAP) { atomicAdd(&bar[XB_TMO], 1u); break; } }
    }
    nloc = mine > 0u ? mine : 1u; nx = cnt > 0u ? cnt : 1u;
}
__device__ __forceinline__ void xcd_barrier(const XcdBarrier& b, const bool leader) {
    asm volatile("s_waitcnt vmcnt(0)" ::: "memory");
    __syncthreads();
    if (leader) {
        unsigned* bar = b.bar;
        __builtin_amdgcn_s_waitcnt(0);
        unsigned nloc = b.st[0], nx = b.st[1];
        if (nloc == 0u) { xcd_barrier_complete(bar, b.x, nloc, nx); b.st[0] = nloc; b.st[1] = nx; }
        const unsigned old = xb_add(&bar[XB_XSUB(b.x)], 1u);
        const unsigned gen = old / nloc;
        if (old + 1u == (gen + 1u) * nloc) {
            __builtin_amdgcn_fence(__ATOMIC_RELEASE, "agent");
            asm volatile("s_waitcnt vmcnt(0)" ::: "memory");
            const unsigned og = xb_add(&bar[XB_TOP], 1u);
            const unsigned tg = og / nx;
            if (og + 1u == (tg + 1u) * nx) xb_add(&bar[XB_TOPGEN], 1u);
            else XB_SPIN(xb_ld(&bar[XB_TOPGEN]) == tg, bar);
            __builtin_amdgcn_fence(__ATOMIC_ACQUIRE, "agent");
            xb_add(&bar[XB_XGEN(b.x)], 1u);
            asm volatile("s_waitcnt vmcnt(0)" ::: "memory");
        } else {
            XB_SPIN(xb_ld(&bar[XB_XGEN(b.x)]) == gen, bar);
            __builtin_amdgcn_fence(__ATOMIC_ACQUIRE, "agent");
            asm volatile("s_waitcnt vmcnt(0)" ::: "memory");
        }
    }
    __syncthreads();
}

#define CAS __attribute__((address_space(4)))
struct Args { const float* in[13]; float* out; unsigned char* ws; int ph_lo, ph_hi; };
struct Frame {
    LAS unsigned char* lds;
    int tid, lane, wave, vcu, G, bx;
    const CAS Args* ap;
    float* H;
    bf16_t* hbc; float* sqc;
    unsigned char* ws;
};

struct TrItem { const float* wp; const float* gk; bf16_t* wt; int srcN, K; float sn; };
__device__ __forceinline__ bool p0_decode(Frame& F, int it, int lane, TrItem& t) {
    const float* pool_norm = F.ap->in[1]; const float* pool_w = F.ap->in[2]; const float* pool_scale = F.ap->in[3];
    const float* mlstm_norm = F.ap->in[4]; const float* w_in = F.ap->in[5]; const float* head_norm = F.ap->in[7]; const float* w_out = F.ap->in[8];
    const float* ffn_norm = F.ap->in[9]; const float* ffn_w_in = F.ap->in[10]; const float* ffn_w_out = F.ap->in[11];
    bf16_t* WPOOL = (bf16_t*)(F.ws + WS_WPOOL); bf16_t* WIN = (bf16_t*)(F.ws + WS_WIN); bf16_t* WOUT = (bf16_t*)(F.ws + WS_WOUT);
    bf16_t* WF1 = (bf16_t*)(F.ws + WS_WF1); bf16_t* WF2 = (bf16_t*)(F.ws + WS_WF2);
    constexpr int I_POOL = 8 * 16, I_IN = 2 * 768, I_OUT = 2 * 256, I_F1 = 4 * 1408, I_F2 = 4 * 704;
    constexpr int NITEMS = I_POOL + I_IN + I_OUT + I_F1 + I_F2;
    if (it >= NITEMS) return false;
    int r = it; const float* W; const float* gk; bf16_t* WT; int srcN, K, k0, n0, drow0; float sn = 1.0f;
    if (r < I_F1) { const int i = r / 1408, rr = r % 1408, kb = rr / 88, nb = rr % 88; n0 = 64 * nb; const int jh = n0 % DFF, isup = n0 / DFF;
        W = ffn_w_in + (size_t)i * D * 2 * DFF; srcN = 2 * DFF; K = D; k0 = 64 * kb; gk = ffn_norm + i * D; WT = WF1 + (size_t)i * 2 * DFF * D; drow0 = (jh / 128) * 256 + isup * 128 + (jh % 128); }
    else if ((r -= I_F1) < I_F2) { const int i = r / 704, rr = r % 704, kb = rr / 16, nb = rr % 16; n0 = 64 * nb;
        W = ffn_w_out + (size_t)i * DFF * D; srcN = D; K = DFF; k0 = 64 * kb; gk = nullptr; WT = WF2 + (size_t)i * D * DFF; drow0 = n0; }
    else if ((r -= I_F2) < I_IN) { const int j = r / 768, rr = r % 768, kb = rr / 48, nb = rr % 48; n0 = 64 * nb;
        W = w_in + (size_t)j * D * INW; srcN = INW; K = D; k0 = 64 * kb; gk = mlstm_norm + j * D; sn = (n0 < NH * DQK) ? 0.08838834764831845f : 1.0f; WT = WIN + (size_t)j * INW_MAIN * D; drow0 = n0; }
    else if ((r -= I_IN) < I_OUT) { const int j = r / 256, rr = r % 256, kb = rr / 16, nb = rr % 16; n0 = 64 * nb;
        W = w_out + (size_t)j * D * D; srcN = D; K = D; k0 = 64 * kb; gk = head_norm + j * D; WT = WOUT + (size_t)j * D * D; drow0 = n0; }
    else { r -= I_OUT; const int mat = r / 16, rr = r % 16, kb = rr / 4, nb = rr % 4, j = mat / 4, g = mat % 4; n0 = 64 * nb;
        W = pool_w + (size_t)mat * 65536; srcN = 256; K = 256; k0 = 64 * kb; gk = pool_norm + j * D + g * 256; sn = pool_scale[j * D + g * 256 + n0 + lane]; WT = WPOOL + (size_t)j * D * 256; drow0 = g * 256 + n0; }
    t.wp = W + (size_t)k0 * srcN + n0 + lane; t.gk = gk ? gk + k0 : nullptr; t.wt = WT + (size_t)drow0 * K + k0; t.srcN = srcN; t.K = K; t.sn = sn;
    return true;
}
#define P0_LOAD(V, GL, T) do { _Pragma("unroll") for (int i_ = 0; i_ < 64; ++i_) V[i_] = (T).wp[(size_t)i_ * (T).srcN]; GL = (T).gk ? (T).gk[lane] : 1.0f; } while (0)
#define P0_FINISH(V, GL, T) do { \
    _Pragma("unroll") for (int i_ = 0; i_ < 64; ++i_) scr[i_ * 65 + lane] = V[i_] * (__builtin_bit_cast(float, __builtin_amdgcn_readlane(__builtin_bit_cast(int, GL), i_)) * (T).sn); \
    LDS_WAIT(); asm volatile("" ::: "memory"); \
    _Pragma("unroll") for (int j_ = 0; j_ < 8; ++j_) { const int n_ = (lane >> 3) + 8 * j_; const LAS float* s_ = scr + (8 * (lane & 7)) * 65 + n_; \
        u32x4 o_; o_.x = cvt_pk_bf16(s_[0 * 65], s_[1 * 65]); o_.y = cvt_pk_bf16(s_[2 * 65], s_[3 * 65]); o_.z = cvt_pk_bf16(s_[4 * 65], s_[5 * 65]); o_.w = cvt_pk_bf16(s_[6 * 65], s_[7 * 65]); \
        *(u32x4*)((T).wt + (size_t)n_ * (T).K + 8 * (lane & 7)) = o_; } \
    LDS_WAIT(); asm volatile("" ::: "memory"); } while (0)
__device__ __forceinline__ int stage_count(int st) { return st == 0 ? 3264 : (st == 3 ? 704 + 1408 + 256 : 704 + 1408 + 384); }
__device__ __forceinline__ int stage_item(int st, int i) {
    if (st == 0) { if (i < 1408) return i; i -= 1408; if (i < 704) return 5632 + i; i -= 704; if (i < 768) return 8448 + i; i -= 768; if (i < 256) return 9984 + i; i -= 256; return 10496 + i; }
    if (i < 704) return 5632 + 704 * st + i; i -= 704;
    if (i < 1408) return 1408 * st + i; i -= 1408;
    if (st == 1) return 9216 + i; if (st == 2) return 9600 + i;
    return 10240 + i;
}
__device__ __forceinline__ void p0_run_items(Frame& F, int st, int worker, int nworkers) {
    LAS float* scr = (LAS float*)(F.lds + F.wave * 16640);
    const int lane = F.lane, cnt = stage_count(st);
    TrItem tA, tB; float vA[64], vB[64], gA, gB;
    int i = worker; bool hasA = (i < cnt) && p0_decode(F, stage_item(st, i), lane, tA), hasB;
    if (hasA) P0_LOAD(vA, gA, tA);
    while (hasA) {
        i += nworkers; hasB = (i < cnt) && p0_decode(F, stage_item(st, i), lane, tB); if (hasB) P0_LOAD(vB, gB, tB);
        P0_FINISH(vA, gA, tA);
        if (!hasB) break;
        i += nworkers; hasA = (i < cnt) && p0_decode(F, stage_item(st, i), lane, tA); if (hasA) P0_LOAD(vA, gA, tA);
        P0_FINISH(vB, gB, tB);
    }
}
__device__ __forceinline__ void p0_prologue(Frame& F) {
    const int gw = F.vcu * NWAVES + F.wave, NGW = F.G * NWAVES, lane = F.lane;
    const float* mlstm_norm = F.ap->in[4]; const float* w_in = F.ap->in[5];
    { const float* x = F.ap->in[0]; float* SSQ = (float*)(F.ws + WS_SSQ); bf16_t* XB = (bf16_t*)(F.ws + WS_HB2);
      for (int m0 = gw * 4; m0 < M; m0 += NGW * 4) { f32x4 v[4][4];
#pragma unroll
          for (int r = 0; r < 4; ++r)
#pragma unroll
              for (int j = 0; j < 4; ++j) v[r][j] = *((const f32x4*)(x + (size_t)(m0 + r) * D) + lane + 64 * j);
#pragma unroll
          for (int r = 0; r < 4; ++r)
#pragma unroll
              for (int j = 0; j < 4; ++j) { u32x2 w; w.x = cvt_pk_bf16(v[r][j].x, v[r][j].y); w.y = cvt_pk_bf16(v[r][j].z, v[r][j].w); *(u32x2*)(XB + (size_t)(m0 + r) * D + 4 * (lane + 64 * j)) = w; }
#pragma unroll
          for (int r = 0; r < 4; ++r) { float s2 = 0.f;
#pragma unroll
              for (int j = 0; j < 4; ++j) s2 += (v[r][j].x * v[r][j].x + v[r][j].y * v[r][j].y) + (v[r][j].z * v[r][j].z + v[r][j].w * v[r][j].w);
              s2 = wave_sum(s2, lane); if (lane == 0) *(f32x4*)(SSQ + (size_t)(m0 + r) * 4) = (f32x4){s2, 0.f, 0.f, 0.f}; } } }
    { bf16_t* WGB = (bf16_t*)(F.ws + WS_WGB); const int gt = F.vcu * NTHREADS + F.tid;
      if (gt < 2 * 16 * D) { const int j = gt / (16 * D), n = (gt / D) % 16, k = gt % D;
          const float v = (n < 8) ? w_in[(size_t)j * D * INW + (size_t)k * INW + INW_MAIN + n] * mlstm_norm[j * D + k] : 0.f;
          WGB[gt] = (bf16_t)(cvt_pk_bf16(v, 0.f) & 0xffffu); } }
}
#undef P0_LOAD
#undef P0_FINISH

template <int WIN>
__device__ __forceinline__ void pool_prep_unit_w(Frame& F, const float* xf, int pm, int g) {
    const int tid = F.tid, seg = F.wave, cq = F.lane, col = g * 256 + 4 * cq;
    const float* SSQ = F.sqc; const bf16_t* hb = F.hbc;
    LAS float* rinv = (LAS float*)(F.lds + PA_RINV_OFF);
    LAS unsigned char* At = F.lds + (cq >> 3) * PA_BLK + ((cq >> 1) & 3) * PA_LG + (cq & 1) * 8;
    const int r0 = pm * 256, tp0 = r0 % SEQ;
    const int first = 32 * seg;
    u32x2 rp[16], rc[2][16];
    const __amdgpu_buffer_rsrc_t rH = __builtin_amdgcn_make_buffer_rsrc((void*)hb, 0, 0x7fffffff, 0x00020000);
    const unsigned voh = (unsigned)(col * 2);
#pragma unroll
    for (int i = 0; i < 16; ++i) { const int rl = first - 16 + i; rp[i] = (u32x2){0u, 0u};
        if (tp0 + rl >= 0) rp[i] = __builtin_amdgcn_raw_buffer_load_b64(rH, voh, (unsigned)((r0 + rl) * D * 2), 0); }
#pragma unroll
    for (int i = 0; i < 16; ++i) rc[0][i] = __builtin_amdgcn_raw_buffer_load_b64(rH, voh, (unsigned)((r0 + first + i) * D * 2), 0);
    __syncthreads();
    if (tid < 272) { const int tp = tp0 - 16 + tid; rinv[tid] = (tp >= 0) ? rinv_of(*(const f32x4*)(SSQ + (size_t)(r0 - 16 + tid) * 4)) : 0.f; }
    __syncthreads();
#pragma unroll
    for (int i = 0; i < 16; ++i) rc[1][i] = __builtin_amdgcn_raw_buffer_load_b64(rH, voh, (unsigned)((r0 + first + 16 + i) * D * 2), 0);
    f32x4 prev[16], cur[16];
#pragma unroll
    for (int i = 0; i < 16; ++i) { const int rl = first - 16 + i;
        const u32x2 h = rp[i]; prev[i] = (f32x4){bflo(h.x), bfhi(h.x), bflo(h.y), bfhi(h.y)} * rinv[16 + rl]; }
    f32x4 S = {0.f, 0.f, 0.f, 0.f};
#pragma unroll
    for (int i = 16 - WIN; i < 16; ++i) S += prev[i];
#pragma unroll
    for (int blk = 0; blk < 2; ++blk) {
#pragma unroll
        for (int i = 0; i < 16; ++i) { const int rl = first + 16 * blk + i; const u32x2 h = rc[blk][i];
            cur[i] = (f32x4){bflo(h.x), bfhi(h.x), bflo(h.y), bfhi(h.y)} * rinv[16 + rl]; }
#pragma unroll
        for (int i = 0; i < 16; ++i) { const int rl = first + 16 * blk + i, tp = tp0 + rl;
            S += cur[i]; S -= (i - WIN >= 0) ? cur[(i - WIN >= 0) ? i - WIN : 0] : prev[(i - WIN >= 0) ? 0 : 16 + i - WIN];
            const float ic = __builtin_amdgcn_rcpf((float)((tp + 1 < WIN) ? (tp + 1) : WIN));
            const f32x4 o = S * ic - cur[i];
            u32x2 w; w.x = cvt_pk_bf16(o[0], o[1]); w.y = cvt_pk_bf16(o[2], o[3]);
            *(LAS u32x2*)(At + (rl >> 4) * (8 * PA_BLK) + (rl & 15) * 16) = w; }
#pragma unroll
        for (int i = 0; i < 16; ++i) prev[i] = cur[i];
    }
    __syncthreads();
}
__device__ __forceinline__ void pool_prep_unit(Frame& F, const float* xf, int pm, int g) {
    if (g == 0) pool_prep_unit_w<2>(F, xf, pm, g); else if (g == 1) pool_prep_unit_w<4>(F, xf, pm, g); else if (g == 2) pool_prep_unit_w<8>(F, xf, pm, g); else pool_prep_unit_w<16>(F, xf, pm, g);
}

__device__ __forceinline__ void gates_part(Frame& F, int j) {
    const bf16_t* HBp = F.hbc; const bf16_t* WGB = (const bf16_t*)(F.ws + WS_WGB) + (size_t)j * 16 * D; const float* SSQ = F.sqc;
    const float* gbias = F.ap->in[6] + j * 8; float* GI = (float*)(F.ws + WS_GI); float* GF = (float*)(F.ws + WS_GF);
    const int lane = F.lane, lr = lane & 15, lg = lane >> 4;
    const int wb = F.wave & 3, kh = F.wave >> 2;
    const int blk = ((F.bx & 7) * 8 + ((F.bx >> 3) & 7)) * 16 + (F.bx >> 6) * 4 + wb;
    const int row0 = blk * 16, rowa = row0 + 4 * lg;
    const bf16_t* ap = HBp + (size_t)(row0 + lr) * D + 8 * lg + 512 * kh; const bf16_t* bp = WGB + (size_t)lr * D + 8 * lg + 512 * kh;
    f32x4 sq[4];
#pragma unroll
    for (int r = 0; r < 4; ++r) sq[r] = *(const f32x4*)(SSQ + (size_t)(rowa + r) * 4);
    const float bias = gbias[lr & 7];
    bf16x8 av[16], bv[16];
#pragma unroll
    for (int ks = 0; ks < 16; ++ks) { av[ks] = *(const bf16x8*)(ap + 32 * ks); bv[ks] = *(const bf16x8*)(bp + 32 * ks); }
    __builtin_amdgcn_sched_barrier(0);
    f32x4 acc = {0.f, 0.f, 0.f, 0.f};
#pragma unroll
    for (int ks = 0; ks < 16; ++ks) acc = __builtin_amdgcn_mfma_f32_16x16x32_bf16(av[ks], bv[ks], acc, 0, 0, 0);
    LAS f32x4* X = (LAS f32x4*)(F.lds + XPOSE_OFF);
    if (kh == 1) X[wb * 64 + lane] = acc;
    __syncthreads();
    if (kh == 0 && lr < 8) {
        acc += X[wb * 64 + lane];
        const int bb = rowa / SEQ, t = rowa % SEQ;
        f32x4 o;
#pragma unroll
        for (int r = 0; r < 4; ++r) { const float val = acc[r] * rinv_of(sq[r]) + bias;
            o[r] = (lr < 4) ? val : ((val > 0.f) ? -__logf(1.0f + __expf(-val)) : (val - __logf(1.0f + __expf(val)))); }
        *(f32x4*)(((lr < 4) ? GI : GF) + (size_t)(bb * NH + (lr & 3)) * SEQ + t) = o;
    }
}

__device__ __forceinline__ float wave_incl_add(float v, int lane) {
#pragma unroll
    for (int o = 1; o < 64; o <<= 1) { const float t = lane_get(v, lane - o); if (lane >= o) v += t; }
    return v;
}
__device__ __forceinline__ float wave_incl_max(float v, int lane) {
#pragma unroll
    for (int o = 1; o < 64; o <<= 1) { const float t = lane_get(v, lane - o); if (lane >= o) v = fmaxf(v, t); }
    return v;
}
__device__ __forceinline__ bf16x8 pack8(const float (&v)[8]) {
    u32x4 w; w.x = cvt_pk_bf16(v[0], v[1]); w.y = cvt_pk_bf16(v[2], v[3]); w.z = cvt_pk_bf16(v[4], v[5]); w.w = cvt_pk_bf16(v[6], v[7]);
    return __builtin_bit_cast(bf16x8, w);
}
typedef __amdgpu_buffer_rsrc_t rsrc_t;
__device__ __forceinline__ rsrc_t mk_rsrc(const void* p) { return __builtin_amdgcn_make_buffer_rsrc((void*)p, 0, 0x7fffffff, 0x00020000); }
__device__ __forceinline__ bf16x8 bld128(rsrc_t r, unsigned voff, unsigned soff) { return __builtin_bit_cast(bf16x8, __builtin_amdgcn_raw_buffer_load_b128(r, voff, soff, 0)); }
__device__ __forceinline__ u32x2 bld64(rsrc_t r, unsigned voff, unsigned soff) { return __builtin_amdgcn_raw_buffer_load_b64(r, voff, soff, 0); }
__device__ __forceinline__ void bst64(rsrc_t r, u32x2 v, unsigned voff, unsigned soff) { __builtin_amdgcn_raw_buffer_store_b64(v, r, voff, soff, 0); }
__device__ __forceinline__ void wst32(rsrc_t r, float v, unsigned voff, unsigned soff) { __builtin_amdgcn_raw_buffer_store_b32(__float_as_uint(v), r, voff, soff, 16); }
__device__ __forceinline__ void wst64(rsrc_t r, u32x2 v, unsigned voff, unsigned soff) { __builtin_amdgcn_raw_buffer_store_b64(v, r, voff, soff, 16); }
__device__ __forceinline__ void wst128(rsrc_t r, f32x4 v, unsigned voff, unsigned soff) { __builtin_amdgcn_raw_buffer_store_b128(__builtin_bit_cast(u32x4, v), r, voff, soff, 16); }
__device__ __forceinline__ void stream_arrive(Frame& F, unsigned* cnt) {
    asm volatile("s_waitcnt vmcnt(0)" ::: "memory");
    __syncthreads();
    if (F.tid == 0) __hip_atomic_fetch_add(cnt, 1u, __ATOMIC_RELAXED, __HIP_MEMORY_SCOPE_AGENT);
}
__device__ __forceinline__ void stream_wait(Frame& F, unsigned* cnt, unsigned need) {
    if (F.tid == 0) {
        unsigned spins = 0;
        while (__hip_atomic_load(cnt, __ATOMIC_RELAXED, __HIP_MEMORY_SCOPE_AGENT) < need) { __builtin_amdgcn_s_sleep(1); if (++spins > (1u << 22)) break; }
        __builtin_amdgcn_fence(__ATOMIC_ACQUIRE, "agent");
        asm volatile("s_waitcnt vmcnt(0)" ::: "memory");
    }
    __syncthreads();
}

__device__ __forceinline__ void pool_gemm(Frame& F, const bf16_t* Wt  , int g, f32x4 (&acc)[2][2][4][2]) {
    const int lane = F.lane, wid = F.wave, wr = wid >> 2, wc = wid & 3, fr = lane & 15, fq = lane >> 4;
#pragma unroll
    for (int a = 0; a < 2; ++a)
#pragma unroll
        for (int b = 0; b < 2; ++b)
#pragma unroll
            for (int m = 0; m < 4; ++m)
#pragma unroll
                for (int n = 0; n < 2; ++n) acc[a][b][m][n] = (f32x4){0.f, 0.f, 0.f, 0.f};
    const rsrc_t rW = mk_rsrc(Wt);
    const unsigned vob = (unsigned)(((g * 256 + 32 * wc + 8 * (fr >> 2) + (fr & 3)) * 256 + 8 * fq) * 2);
    const LAS unsigned char* ap = F.lds + (4 * wr) * (8 * PA_BLK) + fq * PA_LG + fr * 16;
    bf16x8 bfr[2][2], bnx[2][2], bn2[2][2];
#pragma unroll
    for (int bj = 0; bj < 2; ++bj)
#pragma unroll
        for (int n = 0; n < 2; ++n) { bfr[bj][n] = bld128(rW, vob, (unsigned)(((128 * bj + 4 * n) * 256) * 2)); bnx[bj][n] = bld128(rW, vob, (unsigned)(((128 * bj + 4 * n) * 256 + 32) * 2)); }
#pragma unroll
    for (int ks = 0; ks < 8; ++ks) {
        if (ks < 6) {
#pragma unroll
            for (int bj = 0; bj < 2; ++bj)
#pragma unroll
                for (int n = 0; n < 2; ++n) bn2[bj][n] = bld128(rW, vob, (unsigned)(((128 * bj + 4 * n) * 256 + 32 * (ks + 2)) * 2));
        }
#pragma unroll
        for (int ai = 0; ai < 2; ++ai)
#pragma unroll
            for (int m = 0; m < 4; ++m) { const bf16x8 af = *(const LAS bf16x8*)(ap + ((8 * ai + m) * 8 + ks) * PA_BLK);
#pragma unroll
                for (int bj = 0; bj < 2; ++bj)
#pragma unroll
                    for (int n = 0; n < 2; ++n) acc[ai][bj][m][n] = __builtin_amdgcn_mfma_f32_16x16x32_bf16(bfr[bj][n], af, acc[ai][bj][m][n], 0, 0, 0); }
#pragma unroll
        for (int bj = 0; bj < 2; ++bj)
#pragma unroll
            for (int n = 0; n < 2; ++n) { bfr[bj][n] = bnx[bj][n]; bnx[bj][n] = bn2[bj][n]; }
        __builtin_amdgcn_sched_barrier(0);
    }
}

__device__ __forceinline__ void scan1_phase(Frame& F, unsigned* c1) {
    const float* GI = (const float*)(F.ws + WS_GI); const float* GF = (const float*)(F.ws + WS_GF);
    float* TA = (float*)(F.ws + WS_TA); float* TM = (float*)(F.ws + WS_TM); float* TB = (float*)(F.ws + WS_TB); float* MPREV = (float*)(F.ws + WS_MPREV); float* DEC = (float*)(F.ws + WS_DEC);
    const rsrc_t rQ = mk_rsrc(F.H), rVT = mk_rsrc(F.ws + WS_VT), rLOC = mk_rsrc(F.ws + WS_LOC);
    const rsrc_t rTA = mk_rsrc(TA), rTM = mk_rsrc(TM), rTB = mk_rsrc(TB), rMP = mk_rsrc(MPREV), rDEC = mk_rsrc(DEC), rLN = mk_rsrc(F.ws + WS_LOCN);
    LAS float* TAs = (LAS float*)F.lds;
    LAS float* CMs = TAs + 4096;
    LAS float* BCs = CMs + 4096; LAS float* ACs = BCs + 16; LAS float* MPs = ACs + 16; LAS float* MEs = MPs + 16;
    LAS float* WT = (LAS float*)(F.lds + XPOSE_OFF);
    LAS unsigned char* VF = F.lds;
    LAS unsigned char* KS = F.lds + 56 * 1024;
    const int lane = F.lane, wid = F.wave, tid = F.tid, lr = lane & 15, lg = lane >> 4;
    for (int wg = F.bx; wg < NSTREAM * NCH; wg += F.G) {
        const int x_ = wg & 7, of_ = wg >> 3, bb_ = x_ >> 1, c = 8 * (x_ & 1) + (of_ & 7), stream = 4 * bb_ + (of_ >> 3), pub = (c == 0);
        if (c >= NCH - 1) continue;
        const int unit = stream * (NCH - 1) + c;
        const unsigned voff = (unsigned)(lr * (SEQ * 2) + lg * 16);
        bf16x8 vt[16], kf[8]; u32x4 kr[8];
#pragma unroll
        for (int i = 0; i < 16; ++i) { const int vb = 2 * wid + (i >> 3), ks = i & 7; vt[i] = bld128(rVT, voff, (unsigned)(((stream * DV + 16 * vb) * SEQ + c * LC + 32 * ks) * 2)); }
#pragma unroll
        for (int i = 0; i < 8; ++i) kr[i] = __builtin_amdgcn_raw_buffer_load_b128(rQ, (unsigned)((tid >> 4) * 4096 + (tid & 15) * 16), (unsigned)(((bb_ * SEQ + c * LC + 32 * i) * 2048 + NH * DQK + (of_ >> 3) * DQK) * 2), 0);
        __syncthreads();
        for (int cc = 0; cc < 2; ++cc) {
            const int ch = wid + 8 * cc; const size_t base = (size_t)stream * SEQ + ch * LC + 4 * lane;
            const f32x4 f = *(const f32x4*)(GF + base), ii = *(const f32x4*)(GI + base);
            const float p0 = f.x, p1 = p0 + f.y, p2 = p1 + f.z, p3 = p2 + f.w;
            const float incl = wave_incl_add(p3, lane), excl = incl - p3;
            const float b0 = excl + p0, b1 = excl + p1, b2 = excl + p2, b3 = excl + p3;
            const float a0 = ii.x - b0, a1 = ii.y - b1, a2 = ii.z - b2, a3 = ii.w - b3;
            const float q0 = a0, q1 = fmaxf(q0, a1), q2 = fmaxf(q1, a2), q3 = fmaxf(q2, a3);
            const float im = wave_incl_max(q3, lane); float exm = lane_get(im, lane - 1); if (lane == 0) exm = -INFINITY;
            const f32x4 cm = {fmaxf(exm, q0), fmaxf(exm, q1), fmaxf(exm, q2), fmaxf(exm, q3)};
            *(LAS f32x4*)(TAs + ch * LC + 4 * lane) = (f32x4){a0, a1, a2, a3};
            *(LAS f32x4*)(CMs + ch * LC + 4 * lane) = cm;
            if (pub) wst128(rTB, (f32x4){b0, b1, b2, b3}, (unsigned)(lane * 16), (unsigned)((stream * SEQ + ch * LC) * 4));
            if (lane == 63) { BCs[ch] = b3; ACs[ch] = cm.w; }
        }
        __syncthreads();
        if (tid == 0) { float m = 0.f; for (int ch = 0; ch < NCH; ++ch) { MPs[ch] = m; const float me = fmaxf(m, ACs[ch]); MEs[ch] = me; m = BCs[ch] + me; } }
        __syncthreads();
        if (pub) { for (int s2 = tid; s2 < SEQ; s2 += NTHREADS) { wst32(rTA, TAs[s2], (unsigned)(s2 * 4), (unsigned)(stream * SEQ * 4)); wst32(rTM, fmaxf(MPs[s2 >> 8], CMs[s2]), (unsigned)(s2 * 4), (unsigned)(stream * SEQ * 4)); }
                   if (tid < NCH) { wst32(rMP, MPs[tid], (unsigned)(tid * 4), (unsigned)(stream * NCH * 4)); wst32(rDEC, __expf(MPs[tid] - MEs[tid]), (unsigned)(tid * 4), (unsigned)(stream * NCH * 4)); } }
        if (tid < LC) WT[tid] = __expf(TAs[c * LC + tid] - MEs[c]);
#pragma unroll
        for (int i = 0; i < 8; ++i) *(LAS u32x4*)(KS + (32 * i + (tid >> 4)) * 288 + (tid & 15) * 16) = kr[i];
        __syncthreads();
        {
            typedef short v4s __attribute__((ext_vector_type(4)));
            const LAS unsigned char* kp = KS + (8 * lg + (lr >> 2)) * 288 + (16 * wid + 4 * (lr & 3)) * 2;
#pragma unroll
            for (int ks = 0; ks < 8; ++ks) {
                const v4s lo = __builtin_amdgcn_ds_read_tr16_b64_v4i16((LAS v4s*)(kp + (32 * ks) * 288)), hi = __builtin_amdgcn_ds_read_tr16_b64_v4i16((LAS v4s*)(kp + (32 * ks + 4) * 288));
                kf[ks] = (bf16x8){lo[0], lo[1], lo[2], lo[3], hi[0], hi[1], hi[2], hi[3]}; }
        }
        __syncthreads();
        {
#pragma unroll
          for (int i = 0; i < 16; ++i) { const int vb = 2 * wid + (i >> 3), ks = i & 7; *(LAS bf16x8*)(VF + (vb * 8 + ks) * 1024 + lane * 16) = vt[i]; }
          __syncthreads();
          f32x4 acc[16], accn = {0.f, 0.f, 0.f, 0.f};
#pragma unroll
          for (int vb = 0; vb < 16; ++vb) acc[vb] = (f32x4){0.f, 0.f, 0.f, 0.f};
          bf16x8 ones; { const short o1 = (short)0x3F80;
#pragma unroll
              for (int e = 0; e < 8; ++e) ones[e] = o1; }
#pragma unroll
          for (int ks = 0; ks < 8; ++ks) {
              const f32x4 w0 = *(const LAS f32x4*)(WT + 32 * ks + 8 * lg), w1 = *(const LAS f32x4*)(WT + 32 * ks + 8 * lg + 4);
              float sc[8];
#pragma unroll
              for (int e = 0; e < 4; ++e) { sc[e] = bf2f((unsigned short)kf[ks][e]) * w0[e]; sc[4 + e] = bf2f((unsigned short)kf[ks][4 + e]) * w1[e]; }
              const bf16x8 af = pack8(sc);
#pragma unroll
              for (int vb = 0; vb < 16; ++vb) acc[vb] = __builtin_amdgcn_mfma_f32_16x16x32_bf16(af, *(const LAS bf16x8*)(VF + (vb * 8 + ks) * 1024 + lane * 16), acc[vb], 0, 0, 0);
              accn = __builtin_amdgcn_mfma_f32_16x16x32_bf16(af, ones, accn, 0, 0, 0);
          }
          const unsigned vol = (unsigned)(lr * (DQK * 2) + lg * 8);
#pragma unroll
          for (int vb = 0; vb < 16; ++vb) { u32x2 w; w.x = cvt_pk_bf16(acc[vb][0], acc[vb][1]); w.y = cvt_pk_bf16(acc[vb][2], acc[vb][3]);
              wst64(rLOC, w, vol, (unsigned)(((unit * DV + 16 * vb) * DQK + 16 * wid) * 2)); }
          if (lr == 0) wst128(rLN, accn, (unsigned)(lg * 16), (unsigned)((unit * DQK + 16 * wid) * 4));
        }
        stream_arrive(F, c1 + stream * 16);
    }
}
__device__ __forceinline__ void scan2_phase(Frame& F, unsigned* c1, unsigned* c2) {
    const bf16_t* LOC = (const bf16_t*)(F.ws + WS_LOC); const float* LOCN = (const float*)(F.ws + WS_LOCN); const float* DEC = (const float*)(F.ws + WS_DEC);
    const rsrc_t rCST = mk_rsrc(F.ws + WS_CST), rNST = mk_rsrc(F.ws + WS_NST);
    for (int wg = F.bx; wg < 256; wg += F.G) {
        const int x_ = wg & 7, i_ = (x_ & 1) * 32 + (wg >> 3), stream = 4 * (x_ >> 1) + (i_ >> 4), sl = i_ & 15, e = (sl * NTHREADS + F.tid) * 4;
        stream_wait(F, c1 + stream * 16, NCH - 1);
        u32x2 Lb[NCH - 1];
#pragma unroll
        for (int c = 0; c < NCH - 1; ++c) Lb[c] = *(const u32x2*)(LOC + ((size_t)(stream * (NCH - 1) + c) * (DV * DQK) + e));
        float z0 = 0.f; asm volatile("" : "+v"(z0));
        f32x4 C = {z0, z0, z0, z0};
#pragma unroll
        for (int c = 0; c < NCH; ++c) {
            u32x2 w; w.x = cvt_pk_bf16(C[0], C[1]); w.y = cvt_pk_bf16(C[2], C[3]);
            wst64(rCST, w, (unsigned)(e * 2), (unsigned)((stream * NCH + c) * (DV * DQK) * 2));
            if (c < NCH - 1) C = C * DEC[stream * NCH + c] + (f32x4){bflo(Lb[c].x), bfhi(Lb[c].x), bflo(Lb[c].y), bfhi(Lb[c].y)};
        }
        if (sl == 0 && F.tid < DQK / 4) {
            const int en = F.tid * 4; float z1 = 0.f; asm volatile("" : "+v"(z1)); f32x4 Cn = {z1, z1, z1, z1};
            f32x4 Ln[NCH - 1]; float dn[NCH - 1];
#pragma unroll
            for (int c = 0; c < NCH - 1; ++c) { Ln[c] = *(const f32x4*)(LOCN + (size_t)(stream * (NCH - 1) + c) * DQK + en); dn[c] = DEC[stream * NCH + c]; }
#pragma unroll
            for (int c = 0; c < NCH; ++c) { wst128(rNST, Cn, (unsigned)(en * 4), (unsigned)((stream * NCH + c) * DQK * 4));
                if (c < NCH - 1) Cn = Cn * dn[c] + Ln[c]; } }
        stream_arrive(F, c2 + stream * 16);
    }
}

__device__ __forceinline__ void out_phase(Frame& F, unsigned* c2) {
    const float* TA = (const float*)(F.ws + WS_TA); const float* TM = (const float*)(F.ws + WS_TM); const float* TB = (const float*)(F.ws + WS_TB);
    const float* MPREV = (const float*)(F.ws + WS_MPREV); const float* NST = (const float*)(F.ws + WS_NST);
    const rsrc_t rQKO = mk_rsrc(F.H), rVT = mk_rsrc(F.ws + WS_VT), rCST = mk_rsrc(F.ws + WS_CST), rHG = mk_rsrc(F.ws + WS_HG);
    LAS float* As = (LAS float*)F.lds; LAS float* Ms = As + LC; LAS float* Bs = Ms + LC; LAS float* RD = Bs + LC; LAS float* RN = RD + LC;
    LAS float* SSp = (LAS float*)(F.lds + 8192);
    LAS unsigned char* QF = F.lds + 16384;
    LAS unsigned char* PF = F.lds + 81920;
    LAS unsigned char* KF = F.lds + 114688;
    const int lane = F.lane, wid = F.wave, tid = F.tid, lr = lane & 15, lg = lane >> 4;
    const unsigned voq = (unsigned)(lr * 4096 + lg * 16), voc = (unsigned)(lr * 256 + lg * 16), vov = (unsigned)(lr * 8192 + lg * 8);
    const unsigned voo = (unsigned)(lr * 4096 + lg * 8), vog = (unsigned)(lr * 2048 + lg * 8);
    for (int unit = F.bx; unit < NSTREAM * NCH; unit += F.G) {
        const int pm_ = 8 * (unit & 7) + ((unit >> 3) & 7), hh = unit >> 6, bb = pm_ >> 4, c = pm_ & 15, stream = 4 * bb + hh;
        const int rowbase = bb * SEQ + c * LC;
        bf16x8 qv[8];
#pragma unroll
        for (int i = 0; i < 8; ++i) { const int blk = wid * 8 + i, tb = blk >> 2, kq = blk & 3;
            qv[i] = bld128(rQKO, voq, (unsigned)(((rowbase + 16 * tb) * 2048 + hh * DQK + 32 * kq) * 2)); }
        const unsigned sKw = (unsigned)(((rowbase + 16 * (wid >> 2)) * 2048 + NH * DQK + hh * DQK + 32 * (wid & 3)) * 2);
        const bf16x8 kv0 = bld128(rQKO, voq, sKw), kv1 = bld128(rQKO, voq, sKw + (unsigned)(32 * 4096));
        stream_wait(F, c2 + stream * 16, NCH);
        if (tid < LC) { const size_t o = (size_t)stream * SEQ + c * LC + tid; As[tid] = TA[o]; Ms[tid] = TM[o]; Bs[tid] = TB[o]; }
#pragma unroll
        for (int i = 0; i < 8; ++i) *(LAS bf16x8*)(QF + (wid * 8 + i) * 1024 + lane * 16) = qv[i];
        *(LAS bf16x8*)(KF + wid * 1024 + lane * 16) = kv0;
        *(LAS bf16x8*)(KF + 8192 + wid * 1024 + lane * 16) = kv1;
        const float mprev = MPREV[stream * NCH + c];
        const float* nst = NST + (size_t)(stream * NCH + c) * DQK;
        const unsigned sC = (unsigned)(((stream * NCH + c) * DV + 32 * wid) * DQK * 2);
        bf16x8 cfr[2][4];
#pragma unroll
        for (int vbi = 0; vbi < 2; ++vbi)
#pragma unroll
            for (int kq = 0; kq < 4; ++kq) cfr[vbi][kq] = bld128(rCST, voc, sC + (unsigned)(16 * vbi * DQK * 2 + 64 * kq));
        f32x4 nq[4][2];
#pragma unroll
        for (int kq = 0; kq < 4; ++kq) { nq[kq][0] = *(const f32x4*)(nst + 32 * kq + 8 * lg); nq[kq][1] = *(const f32x4*)(nst + 32 * kq + 8 * lg + 4); }
        asm volatile("" :: "v"(nq[3][1]) : "memory");
        bf16x8 nfr[4];
#pragma unroll
        for (int kq = 0; kq < 4; ++kq) { float nv[8];
#pragma unroll
            for (int e = 0; e < 4; ++e) { nv[e] = (lr == 0) ? nq[kq][0][e] : 0.f; nv[4 + e] = (lr == 0) ? nq[kq][1][e] : 0.f; }
            nfr[kq] = pack8(nv); }
        __syncthreads();
        f32x4 acc[2][16];
#pragma unroll
        for (int tb = 0; tb < 16; ++tb) {
            f32x4 a0 = {0.f, 0.f, 0.f, 0.f}, a1 = {0.f, 0.f, 0.f, 0.f};
#pragma unroll
            for (int kq = 0; kq < 4; ++kq) { const bf16x8 q = *(const LAS bf16x8*)(QF + (tb * 4 + kq) * 1024 + lane * 16);
                a0 = __builtin_amdgcn_mfma_f32_16x16x32_bf16(cfr[0][kq], q, a0, 0, 0, 0); a1 = __builtin_amdgcn_mfma_f32_16x16x32_bf16(cfr[1][kq], q, a1, 0, 0, 0); }
            const float it = __expf(mprev - Ms[16 * tb + lr]);
            acc[0][tb] = a0 * it; acc[1][tb] = a1 * it;
        }
        float qn[2], Mt[2], dsum[2] = {0.f, 0.f};
#pragma unroll
        for (int o = 0; o < 2; ++o) { const int tb = o ? (15 - wid) : wid; f32x4 an = {0.f, 0.f, 0.f, 0.f};
#pragma unroll
            for (int kq = 0; kq < 4; ++kq) an = __builtin_amdgcn_mfma_f32_16x16x32_bf16(nfr[kq], *(const LAS bf16x8*)(QF + (tb * 4 + kq) * 1024 + lane * 16), an, 0, 0, 0);
            qn[o] = lane_get(an[0], lr); Mt[o] = Ms[16 * tb + lr]; }
        const unsigned sV0 = (unsigned)(((stream * DV + 32 * wid) * SEQ + c * LC) * 2);
        u32x2 vlo[2], vhi[2];
#pragma unroll
        for (int vbi = 0; vbi < 2; ++vbi) { vlo[vbi] = bld64(rVT, vov, sV0 + (unsigned)(16 * vbi * SEQ * 2)); vhi[vbi] = bld64(rVT, vov, sV0 + (unsigned)(16 * vbi * SEQ * 2 + 32)); }
#define OP_PHASE1(kk) do { const LAS unsigned char* kf_ = KF + ((kk) & 1) * 8192; LAS unsigned char* pf_ = PF + ((kk) & 1) * 16384; \
        _Pragma("unroll") for (int o = 0; o < 2; ++o) { const int tb = o ? (15 - wid) : wid; \
            if (tb >= 2 * (kk)) { const int t = 16 * tb + lr; float p[8]; \
                _Pragma("unroll") for (int mb = 0; mb < 2; ++mb) { f32x4 sa = {0.f, 0.f, 0.f, 0.f}; \
                    _Pragma("unroll") for (int kq = 0; kq < 4; ++kq) sa = __builtin_amdgcn_mfma_f32_16x16x32_bf16(*(const LAS bf16x8*)(kf_ + (mb * 4 + kq) * 1024 + lane * 16), *(const LAS bf16x8*)(QF + (tb * 4 + kq) * 1024 + lane * 16), sa, 0, 0, 0); \
                    const int sb = 32 * (kk) + 16 * mb + 4 * lg; const f32x4 av = *(const LAS f32x4*)(As + sb); \
                    _Pragma("unroll") for (int r = 0; r < 4; ++r) { const float d = (sb + r <= t) ? __expf(av[r] - Mt[o]) : 0.f; const float pv = sa[r] * d; p[mb * 4 + r] = pv; dsum[o] += pv; } } \
                *(LAS bf16x8*)(pf_ + tb * 1024 + lane * 16) = pack8(p); } } } while (0)
        OP_PHASE1(0);
#pragma unroll 1
        for (int ks = 0; ks < 8; ++ks) {
            const LAS unsigned char* pf = PF + (ks & 1) * 16384;
            const int k2 = (ks + 2 < 8) ? ks + 2 : 7, kn = (ks < 7) ? ks + 1 : ks;
            const bf16x8 knext = bld128(rQKO, voq, sKw + (unsigned)(32 * k2 * 4096));
            const u32x4 va0 = {vlo[0].x, vlo[0].y, vhi[0].x, vhi[0].y}, va1 = {vlo[1].x, vlo[1].y, vhi[1].x, vhi[1].y};
            const bf16x8 vf0 = __builtin_bit_cast(bf16x8, va0), vf1 = __builtin_bit_cast(bf16x8, va1);
            __syncthreads();
            if (ks < 7) OP_PHASE1(ks + 1);
#pragma unroll
            for (int tb = 0; tb < 16; ++tb) { if (tb >= 2 * ks) { const bf16x8 pp = *(const LAS bf16x8*)(pf + tb * 1024 + lane * 16);
                acc[0][tb] = __builtin_amdgcn_mfma_f32_16x16x32_bf16(vf0, pp, acc[0][tb], 0, 0, 0); acc[1][tb] = __builtin_amdgcn_mfma_f32_16x16x32_bf16(vf1, pp, acc[1][tb], 0, 0, 0); }
                if ((tb & 3) == 3) __builtin_amdgcn_sched_barrier(0); }
#pragma unroll
            for (int vbi = 0; vbi < 2; ++vbi) { vlo[vbi] = bld64(rVT, vov, sV0 + (unsigned)(16 * vbi * SEQ * 2 + 64 * kn)); vhi[vbi] = bld64(rVT, vov, sV0 + (unsigned)(16 * vbi * SEQ * 2 + 64 * kn + 32)); }
            *(LAS bf16x8*)(KF + (ks & 1) * 8192 + wid * 1024 + lane * 16) = knext;
        }
#undef OP_PHASE1
#define OP_GLOAD(OV, tg) do { _Pragma("unroll") for (int i_ = 0; i_ < 4; ++i_) { const unsigned sO_ = (unsigned)(((rowbase + 16 * (4 * (tg) + i_)) * 2048 + 2 * NH * DQK + hh * DV + 32 * wid) * 2); \
            _Pragma("unroll") for (int vbi = 0; vbi < 2; ++vbi) OV[i_][vbi] = bld64(rQKO, voo, sO_ + 32 * vbi); } } while (0)
#define OP_GOUT(OV, tg) do { _Pragma("unroll") for (int i_ = 0; i_ < 4; ++i_) { const int tb = 4 * (tg) + i_; const float rn = RN[16 * tb + lr]; \
            const unsigned sG_ = (unsigned)(((rowbase + 16 * tb) * D + hh * DV + 32 * wid) * 2); \
            _Pragma("unroll") for (int vbi = 0; vbi < 2; ++vbi) { \
                const float o0 = bflo(OV[i_][vbi].x), o1 = bfhi(OV[i_][vbi].x), o2 = bflo(OV[i_][vbi].y), o3 = bfhi(OV[i_][vbi].y); \
                const float g0 = acc[vbi][tb][0] * rn * __builtin_amdgcn_rcpf(1.0f + __expf(-o0)), g1 = acc[vbi][tb][1] * rn * __builtin_amdgcn_rcpf(1.0f + __expf(-o1)); \
                const float g2 = acc[vbi][tb][2] * rn * __builtin_amdgcn_rcpf(1.0f + __expf(-o2)), g3 = acc[vbi][tb][3] * rn * __builtin_amdgcn_rcpf(1.0f + __expf(-o3)); \
                u32x2 w_; w_.x = cvt_pk_bf16(g0, g1); w_.y = cvt_pk_bf16(g2, g3); __builtin_amdgcn_raw_buffer_store_b64(w_, rHG, vog, sG_ + 32 * vbi, 16); } } } while (0)
        u32x2 ovA[4][2], ovB[4][2];
        OP_GLOAD(ovA, 0);
#pragma unroll
        for (int o = 0; o < 2; ++o) { const int tb = o ? (15 - wid) : wid; const int t = 16 * tb + lr;
            float ds = dsum[o]; ds += lane_xor(ds, 16, lane); ds += lane_xor(ds, 32, lane);
            const float den = __expf(mprev - Mt[o]) * qn[o] + ds;
            if (lg == 0) RD[t] = __builtin_amdgcn_rcpf(fmaxf(fabsf(den), __expf(-(Bs[t] + Mt[o])))); }
        __syncthreads();
#pragma unroll
        for (int tb = 0; tb < 16; ++tb) { const float rd = RD[16 * tb + lr];
            acc[0][tb] *= rd; acc[1][tb] *= rd;
            float ss = (acc[0][tb][0] * acc[0][tb][0] + acc[0][tb][1] * acc[0][tb][1]) + (acc[0][tb][2] * acc[0][tb][2] + acc[0][tb][3] * acc[0][tb][3])
                     + (acc[1][tb][0] * acc[1][tb][0] + acc[1][tb][1] * acc[1][tb][1]) + (acc[1][tb][2] * acc[1][tb][2] + acc[1][tb][3] * acc[1][tb][3]);
            ss += lane_xor(ss, 16, lane); ss += lane_xor(ss, 32, lane);
            if (lg == 0) SSp[wid * LC + 16 * tb + lr] = ss; }
        __syncthreads();
        if (tid < LC) { float ss = 0.f;
#pragma unroll
            for (int w = 0; w < 8; ++w) ss += SSp[w * LC + tid];
            RN[tid] = __builtin_amdgcn_rsqf(ss * (1.0f / DV) + EPS); }
        __syncthreads();
        OP_GLOAD(ovB, 1); __builtin_amdgcn_sched_barrier(0); OP_GOUT(ovA, 0); __builtin_amdgcn_sched_barrier(0);
        OP_GLOAD(ovA, 2); __builtin_amdgcn_sched_barrier(0); OP_GOUT(ovB, 1); __builtin_amdgcn_sched_barrier(0);
        OP_GLOAD(ovB, 3); __builtin_amdgcn_sched_barrier(0); OP_GOUT(ovA, 2); __builtin_amdgcn_sched_barrier(0);
        OP_GOUT(ovB, 3);
#undef OP_GLOAD
#undef OP_GOUT
    }
}

__device__ __forceinline__ void fill_rinv_tables(Frame& F, const pg8::StaticOrder& S) {
    const float* SSQ = F.sqc; LAS float* rl = (LAS float*)(F.lds + RINVL_OFF);
    __syncthreads();
    pg8::Unit u; int n = 0, pm0 = 0; bool same = true;
    for (int i = 0; i < 8 && S.next(i, u); ++i) { if (i == 0) pm0 = u.pm; else same = same && (u.pm == pm0); n = i + 1; }
    if (F.tid < 256) {
        if (same) { const float r = rinv_of(*(const f32x4*)(SSQ + (size_t)(pm0 * 256 + F.tid) * 4)); for (int i = 0; i < n; ++i) rl[i * 256 + F.tid] = r; }
        else { for (int i = 0; i < 8 && S.next(i, u); ++i) rl[i * 256 + F.tid] = rinv_of(*(const f32x4*)(SSQ + (size_t)(u.pm * 256 + F.tid) * 4)); }
    }
    __syncthreads();
}

__device__ __forceinline__ void team_barrier(Frame& F, unsigned* cnt) {
    asm volatile("s_waitcnt vmcnt(0)" ::: "memory");
    __syncthreads();
    if (F.tid == 0) {
        __hip_atomic_fetch_add(cnt, 1u, __ATOMIC_RELAXED, __HIP_MEMORY_SCOPE_AGENT);
        unsigned spins = 0;
        while (__hip_atomic_load(cnt, __ATOMIC_RELAXED, __HIP_MEMORY_SCOPE_AGENT) < 4u) { __builtin_amdgcn_s_sleep(1); if (++spins > (1u << 22)) break; }
        __builtin_amdgcn_fence(__ATOMIC_ACQUIRE, "agent");
        asm volatile("s_waitcnt vmcnt(0)" ::: "memory");
    }
    __syncthreads();
}

__global__ void __launch_bounds__(NTHREADS, 2) mk_fwd(Args args_unused) {
    extern __shared__ __attribute__((aligned(16))) unsigned char lds_raw[];
    {
        LAS unsigned char* l0 = (LAS unsigned char*)lds_raw;
        for (int u = threadIdx.x; u < (LDS_BYTES - LDSCTL_OFF) / 4; u += NTHREADS) ((LAS unsigned*)(l0 + LDSCTL_OFF))[u] = 0u;
        __syncthreads();
    }
    const int wave0 = __builtin_amdgcn_readfirstlane((int)(threadIdx.x >> 6));
    int lo, hi;
    { const CAS Args* ap0 = (const CAS Args*)__builtin_amdgcn_kernarg_segment_ptr(); lo = ap0->ph_lo; hi = ap0->ph_hi; }
    XcdBarrier bar; bar.bar = nullptr; bar.x = 0; bar.st = nullptr;
    if (hi - lo > 1) { const CAS Args* ap0 = (const CAS Args*)__builtin_amdgcn_kernarg_segment_ptr();
        bar = xcd_barrier_post((unsigned*)(ap0->ws + WS_CTL) + CW_BAR, (volatile LAS unsigned*)((LAS unsigned char*)lds_raw + MISC_OFF) + 8); }
    int rep = 0;
#pragma unroll 1
    for (int ph = lo; ph < hi; ) {
        unsigned long long apv = (unsigned long long)__builtin_amdgcn_kernarg_segment_ptr(); asm volatile("" : "+s"(apv));
        const CAS Args* ap = (const CAS Args*)apv;
        int wv = wave0; asm volatile("" : "+s"(wv));
        unsigned ones32 = ~0u; asm volatile("" : "+s"(ones32));
        int lanev = (int)__builtin_amdgcn_mbcnt_hi(ones32, __builtin_amdgcn_mbcnt_lo(ones32, 0u)); asm volatile("" : "+v"(lanev));
        const int tidv = wv * 64 + lanev;
        Frame F;
        F.lds = (LAS unsigned char*)lds_raw;
        F.tid = tidv; F.lane = lanev; F.wave = wv;
        { int gdim = gridDim.x, bx = blockIdx.x; asm volatile("" : "+s"(gdim), "+s"(bx)); F.G = gdim; F.bx = bx; F.vcu = (bx & 7) * (gdim >> 3) + (bx >> 3); }
        F.ap = ap; F.H = ap->out; F.ws = ap->ws;
        struct { unsigned char* ws; } args; args.ws = F.ws;
        int layer = 0, pos = 0, kind;
        if (ph == 0) kind = 0;
        else {
            const int q = ph - 1;
            if (q < 3) { layer = 0; pos = q; } else if (q < 10) { layer = 1; pos = q - 3; } else if (q < 13) { layer = 2; pos = q - 10; } else { layer = 3; pos = q - 13; }
            if ((layer & 1) == 0) kind = (pos == 0) ? 2 : (pos == 1) ? 3 : 4;
            else kind = (pos == 0) ? 5 : (pos == 1) ? 6 : (pos == 2) ? 9 : (pos == 3) ? 7 : (pos == 4) ? 2 : (pos == 5) ? 3 : 4;
        }
        const int jl = layer >> 1;
        const bool second = (layer >= 2);
        const bool poolph = (kind == 2 && (layer & 1) == 0);
        bf16_t* const HBa = (bf16_t*)(args.ws + WS_HB); bf16_t* const HBb = (bf16_t*)(args.ws + WS_HB2);
        float* const SQa = (float*)(args.ws + WS_SSQ); float* const SQb = (float*)(args.ws + WS_SSQ2);
        bf16_t* HB = second ? HBb : HBa; float* SSQ = second ? SQa : SQb;
        F.hbc = poolph ? (second ? HBa : HBb) : HB; F.sqc = poolph ? (second ? SQb : SQa) : SSQ;
        if (kind == 0) { if (PH_ON(0)) p0_prologue(F); }
        else if (kind == 2 || kind == 4) {
            pg8::Gemm g; pg8::StaticOrder S; S.init(M, D, F.G, F.bx);
            const float* basef = nullptr;
            if (kind == 4) { g.A = (const bf16_t*)(args.ws + WS_HID); g.Bt = (const bf16_t*)(args.ws + WS_WF2) + (size_t)layer * D * DFF; g.lda = DFF; g.K = DFF; g.grouped = 0; }
            else if ((layer & 1) == 0) { g.A = nullptr; g.Bt = nullptr; g.lda = D; g.K = 256; g.grouped = 1; }
            else { g.A = (const bf16_t*)(args.ws + WS_HG); g.Bt = (const bf16_t*)(args.ws + WS_WOUT) + (size_t)jl * D * D; g.lda = D; g.K = D; g.grouped = 0; }
            const bool lastf2 = (kind == 4 && layer == DEPTH - 1);
            const bool probe_pass = rep < ((kind == PROBE_KIND || (PROBE_KIND == 12 && kind == 2 && (layer & 1)) || (PROBE_KIND == 13 && kind == 2 && !(layer & 1))) ? PROBE_REP : 0);
            const bool pref = (basef == nullptr);
            pg8::EpiResid E{basef, F.hbc, probe_pass ? (bf16_t*)(args.ws + WS_HG) : HB, probe_pass ? (float*)(args.ws + WS_SSQ2 + 512 * 1024) : SSQ, pref, lastf2 ? F.ap->in[12] : nullptr, F.H, (unsigned*)(args.ws + WS_CTL) + CW_PANEL};
            if (kind == 2 && (layer & 1) == 0) {
                pg8::Unit u0;
                if (S.next(0, u0)) {
                    pool_prep_unit(F, basef, u0.pm, u0.pn);
                    f32x4 pacc[2][2][4][2];
                    pool_gemm(F, (const bf16_t*)(args.ws + WS_WPOOL) + (size_t)jl * D * 256, u0.pn, pacc);
                    __syncthreads();
                    E.lds_base = false;
                    E.fused(pacc, u0, F.wave >> 2, F.wave & 3, F.lane & 15, F.lane >> 4, F.lds, F.wave, F.lane);
                }
            } else
            if (PH_ON(2)) pg8::gemm_phase<pg8::EpiResid, false, true>(F.lds, g, S, E, F.tid, pref ? HB : nullptr);
        }
        else if (kind == 3) {
            pg8::Gemm g{HB, (const bf16_t*)(args.ws + WS_WF1) + (size_t)layer * 2 * DFF * D, D, D, 0}; pg8::StaticOrder S; S.init(M, 2 * DFF, F.G, F.bx);
            fill_rinv_tables(F, S);
            pg8::EpiSwiglu E{(bf16_t*)(args.ws + WS_HID), (const LAS float*)(F.lds + RINVL_OFF)};
            if (PH_ON(3)) pg8::gemm_phase<pg8::EpiSwiglu, true, true>(F.lds, g, S, E, F.tid);
        }
        else if (kind == 5) {
            const bool gates_late = ((F.bx >> 3) & 1) != 0;
            if (!gates_late) gates_part(F, jl);
            pg8::Gemm g{HB, (const bf16_t*)(args.ws + WS_WIN) + (size_t)jl * INW_MAIN * D, D, D, 0}; pg8::StaticOrder S; S.init(M, INW_MAIN, F.G, F.bx);
            fill_rinv_tables(F, S);
            pg8::EpiInProj E{(bf16_t*)F.H, (bf16_t*)(args.ws + WS_KT), (bf16_t*)(args.ws + WS_VT), (const LAS float*)(F.lds + RINVL_OFF), F.lds + XPOSE_OFF + F.wave * 2304};
            if (PH_ON(5)) pg8::gemm_phase<pg8::EpiInProj, true, true>(F.lds, g, S, E, F.tid);
            if (gates_late) { __syncthreads(); gates_part(F, jl); }
        }
        else if (kind == 6) { if (PH_ON(6)) scan1_phase(F, (unsigned*)(args.ws + WS_CTL) + CW_STREAM + jl * 512); }
        else if (kind == 9) { if (PH_ON(6)) scan2_phase(F, (unsigned*)(args.ws + WS_CTL) + CW_STREAM + jl * 512, (unsigned*)(args.ws + WS_CTL) + CW_STREAM + jl * 512 + 256); }
        else { if (PH_ON(7)) out_phase(F, (unsigned*)(args.ws + WS_CTL) + CW_STREAM + jl * 512 + 256); }
        { int cst = -1, cw = 0, cn = 1;
          if (kind == 0) { cst = 0; cw = F.vcu * NWAVES + F.wave; cn = F.G * NWAVES; }
          else if (kind == 3 && layer < 3 && F.bx >= 128) { cst = 1 + layer; cw = (F.bx - 128) * NWAVES + F.wave; cn = (F.G - 128) * NWAVES; }
          if (cst >= 0 && PH_ON(0)) p0_run_items(F, cst, cw, cn); }
        if (rep < ((kind == PROBE_KIND || (PROBE_KIND == 12 && kind == 2 && (layer & 1)) || (PROBE_KIND == 13 && kind == 2 && !(layer & 1))) ? PROBE_REP : 0)) { ++rep; __syncthreads(); continue; }
        rep = 0; ++ph;
        if (ph < hi) {
            const int seam = (kind == 2) ? 0 : (kind == 3) ? 1 : (kind == 7) ? 3 : (kind == 4 && (layer & 1) == 0) ? 2 : -1;
            if (kind == 6 || kind == 9) {   }
            else if (seam >= 0) team_barrier(F, (unsigned*)(args.ws + WS_CTL) + CW_TEAM + ((F.bx & 7) * 8 + ((F.bx >> 3) & 7)) * 16 + layer * 4 + seam);
            else xcd_barrier(bar, F.tid == 0);
        }
    }
}

extern "C" void kernel_launch(void* const* d_in, const int* in_sizes, int n_in, void* d_out, int out_size, void* d_ws, size_t ws_size, hipStream_t stream) {
    static int grid = 0;
    if (grid == 0) {
        if (n_in != 13 || in_sizes[0] != M * D || out_size != M * D || ws_size < WS_END) { fprintf(stderr, "kernel_launch: unexpected shapes (n_in %d, in0 %d, out %d, ws %zu)\n", n_in, n_in > 0 ? in_sizes[0] : -1, out_size, ws_size); grid = -1; return; }
        int dev = 0, cus = 0, per_cu = 0;
        if (hipGetDevice(&dev) != hipSuccess || hipDeviceGetAttribute(&cus, hipDeviceAttributeMultiprocessorCount, dev) != hipSuccess) { grid = -1; return; }
        if (hipFuncSetAttribute((const void*)mk_fwd, hipFuncAttributeMaxDynamicSharedMemorySize, LDS_BYTES) != hipSuccess) { fprintf(stderr, "kernel_launch: hipFuncSetAttribute failed\n"); grid = -1; return; }
        if (hipOccupancyMaxActiveBlocksPerMultiprocessor(&per_cu, (const void*)mk_fwd, NTHREADS, LDS_BYTES) != hipSuccess || per_cu < 1)
            fprintf(stderr, "kernel_launch: note: occupancy query reports %d workgroups per CU\n", per_cu);
        (void)hipGetLastError();
        if (cus != 256) fprintf(stderr, "kernel_launch: note: %d CUs reported; this kernel is laid out for 256 (one workgroup per CU)\n", cus);
        grid = 256;
    }
    if (grid < 0) return;
    if (hipMemsetAsync((char*)d_ws + WS_CTL, 0, CTL_ZERO_BYTES, stream) != hipSuccess) return;
    Args a{};
    for (int i = 0; i < 13; ++i) a.in[i] = (const float*)d_in[i];
    a.out = (float*)d_out; a.ws = (unsigned char*)d_ws;
#if MK_N_LAUNCHES == 1
    a.ph_lo = 0; a.ph_hi = NPHASES;
    hipLaunchKernelGGL(mk_fwd, dim3(grid), dim3(NTHREADS), LDS_BYTES, stream, a);
#else
    for (int p = 0; p < NPHASES; ++p) { a.ph_lo = p; a.ph_hi = p + 1; hipLaunchKernelGGL(mk_fwd, dim3(grid), dim3(NTHREADS), LDS_BYTES, stream, a); }
#endif
}
```
